# Optimizing an MI355X kernel written in HIP

```python
import math
import jax
import jax.numpy as jnp
from jax import lax

D_MODEL = 4096
BATCH = 8
SEQ = 2048
DEPTH = 1

DA_HEADS = 16
DA_DH = 64
DA_DV = 2 * DA_DH
Q_BLOCK = 128
RET_HEADS = 16
RET_DK = 128
RET_DV = 256
RET_CHUNK = 128
PEER_HEADS = 8
PEER_NKEYS = 128
PEER_EXPERTS = PEER_NKEYS * PEER_NKEYS
PEER_DKEY = 256
PEER_DHALF = PEER_DKEY // 2
PEER_TOPK = 16
PEER_BLOCK = 64
NORM_EPS = 1e-5
DEEPNORM_ALPHA = (2.0 * DEPTH) ** 0.25
DEEPNORM_BETA = (8.0 * DEPTH) ** -0.25

DA_QK_W = DA_HEADS * 2 * DA_DH
DA_V_W = DA_HEADS * DA_DV
RET_QK_W = RET_HEADS * RET_DK
RET_V_W = RET_HEADS * RET_DV
IN_SPLITS = (DA_QK_W, DA_QK_W, DA_V_W, RET_QK_W, RET_QK_W, RET_V_W, RET_V_W, D_MODEL, D_MODEL)
IN_IS_VALUE = (0, 0, 1, 0, 0, 1, 0, 0, 0)
IN_COLS = sum(IN_SPLITS)

kernel_name = "hybrid_diffattn_retention_peer_deepnorm"


def _split_points(sizes):
    pts, acc = [], 0
    for s in sizes[:-1]:
        acc += s
        pts.append(acc)
    return pts


def _alibi_slopes(n_heads):
    return 2.0 ** (-8.0 * jnp.arange(1, n_heads + 1, dtype=jnp.float32) / n_heads)


def _layer_norm(x, w, b):
    xf = x.astype(jnp.float32)
    mu = jnp.mean(xf, axis=-1, keepdims=True)
    var = jnp.mean(jnp.square(xf - mu), axis=-1, keepdims=True)
    y = (xf - mu) * lax.rsqrt(var + NORM_EPS) * w.astype(jnp.float32) + b.astype(jnp.float32)
    return y.astype(x.dtype)


def diff_attention(q, k, v, lam_params, subln_w, layer_idx):
    bsz, seq = q.shape[0], q.shape[1]
    lam_init = 0.8 - 0.6 * math.exp(-0.3 * layer_idx)
    lp = lam_params.astype(jnp.float32)
    lam = jnp.exp(jnp.sum(lp[0] * lp[1])) - jnp.exp(jnp.sum(lp[2] * lp[3])) + lam_init
    qh = jnp.transpose(q.astype(jnp.float32), (0, 2, 3, 1, 4)) * (DA_DH ** -0.5)
    kh = jnp.transpose(k.astype(jnp.float32), (0, 2, 3, 1, 4))
    vh = jnp.transpose(v.astype(jnp.float32), (0, 2, 1, 3))
    slopes = _alibi_slopes(DA_HEADS)
    key_pos = jnp.arange(seq, dtype=jnp.int32)

    def one_block(blk):
        start = blk * Q_BLOCK
        qb = lax.dynamic_slice_in_dim(qh, start, Q_BLOCK, axis=3)
        logits = jnp.einsum('bhmqd,bhmkd->bhmqk', qb, kh)
        dist = (start + jnp.arange(Q_BLOCK, dtype=jnp.int32))[:, None] - key_pos[None, :]
        alibi = -slopes[:, None, None] * dist.astype(jnp.float32)
        logits = jnp.where(dist >= 0, logits + alibi[None, :, None], -jnp.inf)
        probs = jax.nn.softmax(logits, axis=-1)
        attn = probs[:, :, 0] - lam * probs[:, :, 1]
        return jnp.einsum('bhqk,bhkv->bhqv', attn, vh)

    out = lax.map(one_block, jnp.arange(seq // Q_BLOCK, dtype=jnp.int32))
    out = jnp.transpose(out, (1, 0, 3, 2, 4)).reshape(bsz, seq, DA_HEADS, DA_DV)
    out = out * lax.rsqrt(jnp.mean(jnp.square(out), axis=-1, keepdims=True) + NORM_EPS)
    out = out * subln_w.astype(jnp.float32) * (1.0 - lam_init)
    return out.reshape(bsz, seq, DA_HEADS * DA_DV).astype(q.dtype)


def retention(q, k, v):
    bsz, seq = q.shape[0], q.shape[1]
    n_chunks = seq // RET_CHUNK
    log_g = jnp.log(1.0 - 2.0 ** (-5.0 - jnp.arange(RET_HEADS, dtype=jnp.float32)))
    idx = jnp.arange(RET_CHUNK, dtype=jnp.float32)
    rel = idx[:, None] - idx[None, :]
    decay_mask = jnp.where(rel >= 0, jnp.exp(log_g[:, None, None] * jnp.maximum(rel, 0.0)), 0.0)
    cross_decay = jnp.exp(log_g[:, None] * (idx + 1.0))[None, :, :, None]
    state_decay = jnp.exp(log_g[:, None] * (RET_CHUNK - 1.0 - idx))[None, :, :, None]
    chunk_decay = jnp.exp(log_g * RET_CHUNK)[None, :, None, None]

    def to_chunks(t):
        d = t.shape[-1]
        t = t.astype(jnp.float32).reshape(bsz, n_chunks, RET_CHUNK, RET_HEADS, d)
        return jnp.transpose(t, (1, 0, 3, 2, 4))

    qc = to_chunks(q)
    kc = to_chunks(k) * (RET_DK ** -0.5)
    vc = to_chunks(v)

    def step(state, inp):
        qi, ki, vi = inp
        inner = jnp.einsum('bhid,bhjd->bhij', qi, ki) * decay_mask
        out = (jnp.einsum('bhij,bhjv->bhiv', inner, vi)
               + jnp.einsum('bhid,bhdv->bhiv', qi, state) * cross_decay)
        state = state * chunk_decay + jnp.einsum('bhjd,bhjv->bhdv', ki * state_decay, vi)
        return state, out

    state0 = jnp.zeros((bsz, RET_HEADS, RET_DK, RET_DV), jnp.float32)
    _, out = lax.scan(step, state0, (qc, kc, vc))
    return jnp.transpose(out, (1, 0, 3, 2, 4)).reshape(bsz, seq, RET_HEADS, RET_DV)


def _head_group_norm(y, w, b, out_dtype):
    bsz, seq = y.shape[0], y.shape[1]
    mu = jnp.mean(y, axis=-1, keepdims=True)
    var = jnp.mean(jnp.square(y - mu), axis=-1, keepdims=True)
    y = ((y - mu) * lax.rsqrt(var + NORM_EPS)).reshape(bsz, seq, -1)
    return (y * w.astype(jnp.float32) + b.astype(jnp.float32)).astype(out_dtype)


def peer(x, w_query, sub_keys, u_table, v_table):
    bsz, seq, dm = x.shape
    n_tok = bsz * seq
    xt = x.reshape(n_tok, dm)
    q = (xt @ w_query).reshape(n_tok, PEER_HEADS, 2, PEER_DHALF).astype(jnp.float32)
    scores = jnp.einsum('thcd,hcnd->thcn', q, sub_keys.astype(jnp.float32))
    s_top, i_top = lax.top_k(scores, PEER_TOPK)
    cand_s = s_top[:, :, 0, :, None] + s_top[:, :, 1, None, :]
    cand_i = i_top[:, :, 0, :, None] * PEER_NKEYS + i_top[:, :, 1, None, :]
    n_cand = PEER_TOPK * PEER_TOPK
    best_s, best_pos = lax.top_k(cand_s.reshape(n_tok, PEER_HEADS, n_cand), PEER_TOPK)
    best_i = jnp.take_along_axis(cand_i.reshape(n_tok, PEER_HEADS, n_cand), best_pos, axis=-1)
    gate = jax.nn.softmax(best_s, axis=-1)
    n_sel = PEER_HEADS * PEER_TOPK
    n_blk = n_tok // PEER_BLOCK
    xs = (xt.reshape(n_blk, PEER_BLOCK, dm),
          best_i.reshape(n_blk, PEER_BLOCK, n_sel),
          gate.reshape(n_blk, PEER_BLOCK, n_sel).astype(x.dtype))

    def one_block(args):
        xb, ib, gb = args
        u = jnp.take(u_table, ib, axis=0)
        h = jnp.einsum('tkd,td->tk', u, xb)
        act = jax.nn.gelu(h, approximate=False) * gb
        vv = jnp.take(v_table, ib, axis=0)
        return jnp.einsum('tk,tkd->td', act, vv)

    y = lax.map(one_block, xs)
    return y.reshape(bsz, seq, dm).astype(x.dtype)


def setup_inputs(seed: int = 0) -> dict:
    key = jax.random.key(seed)
    ks = jax.random.split(key, 18)
    f32 = jnp.float32
    beta = DEEPNORM_BETA

    def nrm(k, shape, scale):
        return jax.random.normal(k, shape, f32) * scale

    col_scale = jnp.concatenate([jnp.full((n,), beta if is_v else 1.0, f32)
                                 for n, is_v in zip(IN_SPLITS, IN_IS_VALUE)])
    return {
        "x": nrm(ks[0], (BATCH, SEQ, D_MODEL), 1.0),
        "w_in": nrm(ks[1], (DEPTH, D_MODEL, IN_COLS), D_MODEL ** -0.5) * col_scale,
        "da_lambda": nrm(ks[2], (DEPTH, 4, DA_DH), 0.1),
        "da_subln_w": 1.0 + nrm(ks[3], (DEPTH, DA_DV), 0.02),
        "w_da_out": nrm(ks[4], (DEPTH, DA_V_W, D_MODEL), beta * DA_V_W ** -0.5),
        "ret_gn_w": 1.0 + nrm(ks[5], (DEPTH, RET_V_W), 0.02),
        "ret_gn_b": nrm(ks[6], (DEPTH, RET_V_W), 0.02),
        "w_ret_out": nrm(ks[7], (DEPTH, RET_V_W, D_MODEL), beta * RET_V_W ** -0.5),
        "w_out": nrm(ks[8], (DEPTH, D_MODEL, D_MODEL), beta * D_MODEL ** -0.5),
        "ln1_w": 1.0 + nrm(ks[9], (DEPTH, D_MODEL), 0.02),
        "ln1_b": nrm(ks[10], (DEPTH, D_MODEL), 0.02),
        "peer_w_query": nrm(ks[11], (DEPTH, D_MODEL, PEER_HEADS * PEER_DKEY), D_MODEL ** -0.5),
        "peer_sub_keys": nrm(ks[12], (DEPTH, PEER_HEADS, 2, PEER_NKEYS, PEER_DHALF), PEER_DHALF ** -0.5),
        "peer_u": nrm(ks[13], (DEPTH, PEER_EXPERTS, D_MODEL), D_MODEL ** -0.5),
        "peer_v": nrm(ks[14], (DEPTH, PEER_EXPERTS, D_MODEL), beta),
        "ln2_w": 1.0 + nrm(ks[15], (DEPTH, D_MODEL), 0.02),
        "ln2_b": nrm(ks[16], (DEPTH, D_MODEL), 0.02),
    }


def reference(x, w_in, da_lambda, da_subln_w, w_da_out, ret_gn_w, ret_gn_b, w_ret_out,
              w_out, ln1_w, ln1_b, peer_w_query, peer_sub_keys, peer_u, peer_v, ln2_w, ln2_b):
    bsz, seq, _ = x.shape
    for l in range(DEPTH):
        proj = jnp.einsum('bsd,dc->bsc', x, w_in[l])
        da_q, da_k, da_v, r_q, r_k, r_v, r_g, gate_a, gate_r = jnp.split(
            proj, _split_points(IN_SPLITS), axis=-1)
        a = diff_attention(da_q.reshape(bsz, seq, DA_HEADS, 2, DA_DH),
                           da_k.reshape(bsz, seq, DA_HEADS, 2, DA_DH),
                           da_v.reshape(bsz, seq, DA_HEADS, DA_DV),
                           da_lambda[l], da_subln_w[l], l)
        a = a @ w_da_out[l]
        r = retention(r_q.reshape(bsz, seq, RET_HEADS, RET_DK),
                      r_k.reshape(bsz, seq, RET_HEADS, RET_DK),
                      r_v.reshape(bsz, seq, RET_HEADS, RET_DV))
        r = _head_group_norm(r, ret_gn_w[l], ret_gn_b[l], x.dtype) * jax.nn.silu(r_g)
        r = r @ w_ret_out[l]
        merged = jax.nn.sigmoid(gate_a) * a + jax.nn.sigmoid(gate_r) * r
        x = _layer_norm(DEEPNORM_ALPHA * x + merged @ w_out[l], ln1_w[l], ln1_b[l])
        y = peer(x, peer_w_query[l], peer_sub_keys[l], peer_u[l], peer_v[l])
        x = _layer_norm(DEEPNORM_ALPHA * x + y, ln2_w[l], ln2_b[l])
    return x
```

```cpp
#include <cstdio>
#include <cstdint>
#include <cmath>
#include <hip/hip_runtime.h>
#include <cstdio>
#include <cstdint>
namespace pg8 {
#define PG8_LAS __attribute__((address_space(3)))
typedef unsigned short bf16_t;
typedef short bf16x8 __attribute__((ext_vector_type(8)));
typedef float f32x4 __attribute__((ext_vector_type(4)));
typedef unsigned u32x4 __attribute__((ext_vector_type(4)));
constexpr int BM = 256, BK = 64, HALF = 128, HTB = HALF * BK * 2  , STAGE_BYTES = 8 * HTB, NXCD = 8, WGM = 8;

__host__ __device__ __forceinline__ int lds_byte(int r, int c) { const int st = (r >> 4) * 2 + (c >> 5), rr = r & 15, cc = c & 31, ob = rr * 64 + cc * 2; return st * 1024 + (ob ^ (((ob >> 9) & 1) << 5)); }
__host__ __device__ __forceinline__ void stage_rc(int b, int& R, int& C) { const int st = b / 1024, sb = b % 1024, swz = sb ^ (((sb >> 9) & 1) << 5); R = (st >> 1) * 16 + swz / 64; C = (st & 1) * 32 + (swz % 64) / 2; }
__host__ __device__ __forceinline__ int perm32(int rho) { const int n = rho >> 4, i = rho & 15; return 8 * (i >> 2) + 4 * n + (i & 3); }

struct Unit { int pm, pn; };
struct Gemm { const bf16_t* A; const bf16_t* Bt; int M, N, K; int kmul = 1;   };

struct StaticOrder {
    int nM, nN, nwg, G, c;
    __host__ __device__ void init(int M, int N, int G_, int c_) { nM = M / BM; nN = N / BM; nwg = nM * nN; G = G_; c = c_; }
    __host__ __device__ bool next(int i, Unit& u) const {
        const long L = (long)i * G + c; if (L >= nwg) return false;
        int wgid = (int)L; { const int q = nwg / NXCD, r = nwg % NXCD, xcd = wgid % NXCD, off = wgid / NXCD; wgid = (xcd < r ? xcd * (q + 1) : r * (q + 1) + (xcd - r) * q) + off; }
        const int nig = WGM * nN, gid = wgid / nig, fm = gid * WGM, gsz = (nM - fm) < WGM ? (nM - fm) : WGM;
        u.pm = fm + ((wgid % nig) % gsz); u.pn = (wgid % nig) / gsz; return true;
    }
    __device__ __forceinline__ void a_ready(const Unit&) const {}
    __device__ __forceinline__ void done(const Unit&) const {}
};

__device__ __forceinline__ unsigned cvt_pk_bf16(float lo, float hi) { unsigned r; asm volatile("v_cvt_pk_bf16_f32 %0, %1, %2" : "=v"(r) : "v"(lo), "v"(hi)); return r; }
typedef float f32x2 __attribute__((ext_vector_type(2)));
__device__ __forceinline__ f32x2 gelu_pk(f32x2 v) {
    const f32x2 av = __builtin_elementwise_abs(v), d = av * 0.2316418882f + 1.0f;
    f32x2 t; t.x = __builtin_amdgcn_rcpf(d.x); t.y = __builtin_amdgcn_rcpf(d.y);
    f32x2 q = t * 0.5307027145f + (-0.7265760135f); q = q * t + 0.7107068705f; q = q * t + (-0.142248368f); q = q * t + 0.127414796f; q = q * t;
    const f32x2 s = (v * v) * (-0.72134752044f);
    f32x2 e; e.x = __builtin_amdgcn_exp2f(s.x); e.y = __builtin_amdgcn_exp2f(s.y);
    const f32x2 m = v * (q * e), r = v - m;
    f32x2 o; o.x = v.x < 0.f ? m.x : r.x; o.y = v.y < 0.f ? m.y : r.y; return o;
}

template <int ACT  > struct EpiBf16 {
    static constexpr bool PERM = true, AFTER_DRAIN = false; static_assert(ACT == 0 || ACT == 1, "EpiBf16: ACT is 0 (none) or 1 (gelu_pk)");
    bf16_t* O; int ldc; const float* bias; int split_cols; size_t split_stride; float scale0;
    __device__ __forceinline__ void operator()(const f32x4 (&acc)[2][2][4][2], const Unit& u, int wr, int wc, int fr, int fq) const {
        const int row0 = u.pm * BM + wr * 64 + fr; int colt = u.pn * BM; bf16_t* base = O;
        float sc = 1.f; if (split_cols) { const int t = colt / split_cols; base += (size_t)t * split_stride; colt -= t * split_cols; if (t == 0) sc = scale0; }
        const int col0 = colt + wc * 32 + 8 * fq, bcol0 = u.pn * BM + wc * 32 + 8 * fq;
        f32x4 bv[2][2];
#pragma unroll
        for (int bj = 0; bj < 2; ++bj)
#pragma unroll
            for (int n = 0; n < 2; ++n) bv[bj][n] = bias ? *(const f32x4*)(bias + bcol0 + bj * HALF + 4 * n) : (f32x4){0.f, 0.f, 0.f, 0.f};
#pragma unroll
        for (int ai = 0; ai < 2; ++ai)
#pragma unroll
            for (int m = 0; m < 4; ++m) { bf16_t* rowp = base + (size_t)(row0 + ai * HALF + m * 16) * ldc + col0;
#pragma unroll
                for (int bj = 0; bj < 2; ++bj) { f32x4 v0 = acc[ai][bj][m][0] + bv[bj][0], v1 = acc[ai][bj][m][1] + bv[bj][1];
                    if (ACT == 1) { f32x2 a = gelu_pk((f32x2){v0[0], v0[1]}), b = gelu_pk((f32x2){v0[2], v0[3]}), c = gelu_pk((f32x2){v1[0], v1[1]}), d = gelu_pk((f32x2){v1[2], v1[3]});
                        v0 = (f32x4){a.x, a.y, b.x, b.y}; v1 = (f32x4){c.x, c.y, d.x, d.y}; }
                    v0 = v0 * sc; v1 = v1 * sc; u32x4 w; w.x = cvt_pk_bf16(v0[0], v0[1]); w.y = cvt_pk_bf16(v0[2], v0[3]); w.z = cvt_pk_bf16(v1[0], v1[1]); w.w = cvt_pk_bf16(v1[2], v1[3]);
                    *(u32x4*)(rowp + bj * HALF) = w; } }
    }
};
typedef int v8i32_t __attribute__((ext_vector_type(8))); typedef int v6i32_t __attribute__((ext_vector_type(6))); typedef int v4i32_t __attribute__((ext_vector_type(4)));
__device__ __forceinline__ v6i32_t six(v8i32_t v) { return __builtin_shufflevector(v, v, 0, 1, 2, 3, 4, 5); }
__device__ __forceinline__ bf16x8 lo8(v8i32_t v) { return __builtin_bit_cast(bf16x8, __builtin_shufflevector(v, v, 0, 1, 2, 3)); }
__device__ __forceinline__ bf16x8 hi8(v8i32_t v) { return __builtin_bit_cast(bf16x8, __builtin_shufflevector(v, v, 4, 5, 6, 7)); }
__device__ __forceinline__ v8i32_t cat8(bf16x8 a, bf16x8 b) { const v4i32_t x = __builtin_bit_cast(v4i32_t, a), y = __builtin_bit_cast(v4i32_t, b); return (v8i32_t){x[0], x[1], x[2], x[3], y[0], y[1], y[2], y[3]}; }
typedef int v2i32_t __attribute__((ext_vector_type(2)));
template <int F> struct FragT { typedef v8i32_t type; };

template <int F> __device__ __forceinline__ v8i32_t ldfrag(const PG8_LAS unsigned char* p) {
    const v4i32_t x = *(const PG8_LAS v4i32_t*)p; const v4i32_t y = *(const PG8_LAS v4i32_t*)(p + 1024);
    v8i32_t r = (v8i32_t){x[0], x[1], x[2], x[3], y[0], y[1], y[2], y[3]};
    return r;
}
template <class Epi, class Sched, bool ALIGN_EPI = false, bool SP2 = false, int FP8 = 0  >
__device__ __forceinline__ void gemm_phase(PG8_LAS unsigned char* lds, const Gemm g, const Sched& S, const Epi& E) {
    const int tid = threadIdx.x, wid = __builtin_amdgcn_readfirstlane(tid >> 6), lane = tid & 63, wr = wid >> 2, wc = wid & 3, fr = lane & 15, fq = lane >> 4;
    const int K = g.K, nt = K / BK;
    unsigned voffA[2], voffB[2];
#pragma unroll
    for (int i = 0; i < 2; ++i) { int R, C; stage_rc(tid * 16 + i * 8192, R, C); const int Rb = Epi::PERM ? ((R & ~31) + perm32(R & 31)) : R;
        if constexpr (FP8 == 2) { const int p = C >> 3; C = 8 * ((p < 4) ? 2 * p : 2 * (p - 4) + 1); }
        voffA[i] = (unsigned)(R * K + C) * 2u; voffB[i] = (unsigned)(Rb * K + C) * 2u; }
    const size_t kstep = (size_t)(BK * 2) * (size_t)g.kmul;
    const size_t hstep = (size_t)HALF * K * 2;
    const size_t tstep = 2 * hstep;
    const unsigned ldsw = (unsigned)wid * 1024u;
    const int aoff = lds_byte(wr * 64 + fr, fq * 8), boff = lds_byte(wc * 32 + fr, fq * 8);
#define PG8_SA(b, h) (((b) * 2 + (h)) * HTB)
#define PG8_SB(b, h) ((4 + (b) * 2 + (h)) * HTB)
#define PG8_STAGE(bufoff, gbase, voff) do { _Pragma("unroll") for (int _i = 0; _i < 2; ++_i) \
        __builtin_amdgcn_global_load_lds((const unsigned*)((const char*)(gbase) + (voff)[_i]), (PG8_LAS unsigned*)(lds + (bufoff) + ldsw + _i * 8192), 16, 0, 0); } while (0)
#define PG8_LDA(dst, b, h) do { _Pragma("unroll") for (int m = 0; m < 4; ++m) dst[m] = ldfrag<FP8>(lds + PG8_SA(b, h) + aoff + m * 2048); } while (0)
#define PG8_LDB(dst, b, h) do { _Pragma("unroll") for (int n = 0; n < 2; ++n) dst[n] = ldfrag<FP8>(lds + PG8_SB(b, h) + boff + n * 2048); } while (0)
#define PG8_MMA(ai, bj, At, Bt) do { if constexpr (FP8 == 2) { asm volatile("" : "+v"(At[0]), "+v"(At[1]), "+v"(At[2]), "+v"(At[3]), "+v"(Bt[0]), "+v"(Bt[1])); }     \
        __builtin_amdgcn_s_setprio(1); _Pragma("unroll") for (int m = 0; m < 4; ++m) _Pragma("unroll") for (int n = 0; n < 2; ++n) { \
        if constexpr (FP8 == 1) { asm volatile("s_nop 1\n\tv_mfma_scale_f32_16x16x128_f8f6f4 %0, %1, %2, %0, %3, %3 op_sel_hi:[0,0,0]" : "+v"(acc[ai][bj][m][n]) : "v"(Bt[n]), "v"(At[m]), "v"(f8scale)); } \
        else if constexpr (FP8 == 2) { asm volatile("s_nop 1\n\tv_mfma_scale_f32_16x16x128_f8f6f4 %0, %1, %2, %0, %3, %3 op_sel_hi:[0,0,0] cbsz:2 blgp:2" : "+v"(acc[ai][bj][m][n]) : "v"(six(Bt[n])), "v"(six(At[m])), "v"(f8scale)); } \
        else { acc[ai][bj][m][n] = __builtin_amdgcn_mfma_f32_16x16x32_bf16(lo8(Bt[n]), lo8(At[m]), acc[ai][bj][m][n], 0, 0, 0); \
               acc[ai][bj][m][n] = __builtin_amdgcn_mfma_f32_16x16x32_bf16(hi8(Bt[n]), hi8(At[m]), acc[ai][bj][m][n], 0, 0, 0); } } \
        __builtin_amdgcn_s_setprio(0); } while (0)
#define PG8_WAIT_V(n) asm volatile("s_waitcnt vmcnt(" #n ")" ::: "memory")
#define PG8_WAIT_V8F() do { if (fresh) asm volatile("s_waitcnt vmcnt(%0)" :: "n"(10 + Epi::NVM) : "memory"); else asm volatile("s_waitcnt vmcnt(8)" ::: "memory"); } while (0)
#define PG8_WAIT_L(n) asm volatile("s_waitcnt lgkmcnt(" #n ")" ::: "memory")
#define PG8_BAR __builtin_amdgcn_s_barrier()
#define PG8_SCHED __builtin_amdgcn_sched_barrier(0)
#define PG8_SP2_ITER(W8) do { const bool last = (t == nt - 2); const char* a1 = cA + (size_t)(t + 1) * kstep; const char* a2 = last ? nA : cA + (size_t)(t + 2) * kstep; const char* b2 = last ? nB : cB + (size_t)(t + 2) * kstep; const char* a3 = a2 + kstep; const char* b3 = b2 + kstep; if (last && has_next) S.a_ready(nxt); PG8_LDB(B0, 0, 0); PG8_LDB(B1, 0, 1); PG8_SCHED; PG8_LDA(At, 0, 0); PG8_STAGE(PG8_SA(1, 1), a1 + hstep, voffA); W8; PG8_WAIT_L(0); PG8_BAR; PG8_MMA(0, 0, At, B0); PG8_MMA(0, 1, At, B1); PG8_BAR; PG8_SCHED; PG8_LDA(At, 0, 1); PG8_STAGE(PG8_SB(0, 0), b2, voffB); PG8_STAGE(PG8_SB(0, 1), b2 + hstep, voffB); PG8_STAGE(PG8_SA(0, 0), a2, voffA); W8; PG8_WAIT_L(0); PG8_BAR; PG8_MMA(1, 0, At, B0); PG8_MMA(1, 1, At, B1); PG8_BAR; PG8_SCHED; PG8_LDB(B0, 1, 0); PG8_LDB(B1, 1, 1); PG8_SCHED; PG8_LDA(At, 1, 0); PG8_STAGE(PG8_SA(0, 1), a2 + hstep, voffA); W8; PG8_WAIT_L(0); PG8_BAR; PG8_MMA(0, 0, At, B0); PG8_MMA(0, 1, At, B1); PG8_BAR; PG8_SCHED; PG8_LDA(At, 1, 1); PG8_STAGE(PG8_SB(1, 0), b3, voffB); PG8_STAGE(PG8_SB(1, 1), b3 + hstep, voffB); PG8_STAGE(PG8_SA(1, 0), a3, voffA); PG8_WAIT_V(8); PG8_WAIT_L(0); PG8_BAR; PG8_MMA(1, 0, At, B0); PG8_MMA(1, 1, At, B1); PG8_BAR; PG8_SCHED; } while (0)
    Unit cur, nxt; int ui = 0;
    if (!S.next(0, cur)) return;
    f32x4 acc[2][2][4][2];
#pragma unroll
    for (int a = 0; a < 2; ++a)
#pragma unroll
        for (int b = 0; b < 2; ++b)
#pragma unroll
            for (int m = 0; m < 4; ++m)
#pragma unroll
                for (int n = 0; n < 2; ++n) acc[a][b][m][n] = (f32x4){0.f, 0.f, 0.f, 0.f};
    const int f8scale = 0x7f7f7f7f;
    typedef typename FragT<FP8>::type frag_t;
    frag_t At[4], B0[2], B1[2];
    const char* cA = (const char*)g.A + (size_t)cur.pm * tstep; const char* cB = (const char*)g.Bt + (size_t)cur.pn * tstep;
    S.a_ready(cur);
    if constexpr (SP2) {
        PG8_STAGE(PG8_SB(0, 0), cB, voffB); PG8_STAGE(PG8_SB(0, 1), cB + hstep, voffB); PG8_STAGE(PG8_SA(0, 0), cA, voffA); PG8_STAGE(PG8_SA(0, 1), cA + hstep, voffA);
        if (wr == 1) PG8_BAR;
        PG8_WAIT_V(2); PG8_BAR;
        PG8_STAGE(PG8_SB(1, 0), cB + kstep, voffB); PG8_STAGE(PG8_SA(1, 0), cA + kstep, voffA); PG8_STAGE(PG8_SB(1, 1), cB + hstep + kstep, voffB);
        PG8_WAIT_V(6); PG8_BAR;
    } else {
        PG8_STAGE(PG8_SB(0, 0), cB, voffB); PG8_STAGE(PG8_SA(0, 0), cA, voffA); PG8_STAGE(PG8_SB(0, 1), cB + hstep, voffB); PG8_STAGE(PG8_SA(0, 1), cA + hstep, voffA);
        if (wr == 1) PG8_BAR;
        PG8_WAIT_V(4); PG8_BAR;
        PG8_STAGE(PG8_SB(1, 0), cB + kstep, voffB); PG8_STAGE(PG8_SA(1, 0), cA + kstep, voffA); PG8_STAGE(PG8_SB(1, 1), cB + hstep + kstep, voffB);
        PG8_WAIT_V(6); PG8_BAR;
    }
    for (;;) {
        const bool has_next = S.next(ui + 1, nxt);
        const char* nA = has_next ? (const char*)g.A + (size_t)nxt.pm * tstep : cA; const char* nB = has_next ? (const char*)g.Bt + (size_t)nxt.pn * tstep : cB;
        if constexpr (SP2) {
            int t = 0;
            { const bool fresh = (FP8 != 0) && (ui > 0) && (Epi::NVM > 0); PG8_SP2_ITER(PG8_WAIT_V8F()); }
            for (t = 2; t < nt; t += 2) { PG8_SP2_ITER(PG8_WAIT_V(8)); }
        } else
        for (int t = 0; t < nt; t += 2) {
            const bool last = (t == nt - 2); const bool fresh = (FP8 != 0) && (t == 0) && (ui > 0) && (Epi::NVM > 0);
            const char* a1 = cA + (size_t)(t + 1) * kstep;
            const char* a2 = last ? nA : cA + (size_t)(t + 2) * kstep; const char* b2 = last ? nB : cB + (size_t)(t + 2) * kstep;
            const char* a3 = a2 + kstep; const char* b3 = b2 + kstep;
            if (last && has_next) S.a_ready(nxt);
            if constexpr (SP2) {
            PG8_LDB(B0, 0, 0); PG8_LDB(B1, 0, 1); PG8_SCHED; PG8_LDA(At, 0, 0); PG8_STAGE(PG8_SA(1, 1), a1 + hstep, voffA);
            PG8_WAIT_V8F(); PG8_WAIT_L(0); PG8_BAR; PG8_MMA(0, 0, At, B0); PG8_MMA(0, 1, At, B1); PG8_BAR; PG8_SCHED;
            PG8_LDA(At, 0, 1); PG8_STAGE(PG8_SB(0, 0), b2, voffB); PG8_STAGE(PG8_SB(0, 1), b2 + hstep, voffB); PG8_STAGE(PG8_SA(0, 0), a2, voffA);
            PG8_WAIT_V8F(); PG8_WAIT_L(0); PG8_BAR; PG8_MMA(1, 0, At, B0); PG8_MMA(1, 1, At, B1); PG8_BAR; PG8_SCHED;
            PG8_LDB(B0, 1, 0); PG8_LDB(B1, 1, 1); PG8_SCHED; PG8_LDA(At, 1, 0); PG8_STAGE(PG8_SA(0, 1), a2 + hstep, voffA);
            PG8_WAIT_V8F(); PG8_WAIT_L(0); PG8_BAR; PG8_MMA(0, 0, At, B0); PG8_MMA(0, 1, At, B1); PG8_BAR; PG8_SCHED;
            PG8_LDA(At, 1, 1); PG8_STAGE(PG8_SB(1, 0), b3, voffB); PG8_STAGE(PG8_SB(1, 1), b3 + hstep, voffB); PG8_STAGE(PG8_SA(1, 0), a3, voffA);
            PG8_WAIT_V(8); PG8_WAIT_L(0); PG8_BAR; PG8_MMA(1, 0, At, B0); PG8_MMA(1, 1, At, B1); PG8_BAR; PG8_SCHED;
            } else {
            PG8_LDB(B0, 0, 0); PG8_SCHED; PG8_LDA(At, 0, 0); PG8_STAGE(PG8_SA(1, 1), a1 + hstep, voffA);
            PG8_WAIT_L(8); PG8_BAR; PG8_WAIT_L(0); PG8_MMA(0, 0, At, B0); PG8_BAR; PG8_SCHED;
            PG8_LDB(B1, 0, 1); PG8_STAGE(PG8_SB(0, 0), b2, voffB);
            PG8_BAR; PG8_WAIT_L(0); PG8_MMA(0, 1, At, B1); PG8_BAR;
            PG8_LDA(At, 0, 1); PG8_STAGE(PG8_SA(0, 0), a2, voffA);
            PG8_BAR; PG8_WAIT_L(0); PG8_MMA(1, 0, At, B0); PG8_BAR; PG8_SCHED;
            PG8_STAGE(PG8_SB(0, 1), b2 + hstep, voffB);
            PG8_WAIT_V(6); PG8_BAR; PG8_MMA(1, 1, At, B1); PG8_BAR;
            PG8_LDB(B0, 1, 0); PG8_SCHED; PG8_LDA(At, 1, 0); PG8_STAGE(PG8_SA(0, 1), a2 + hstep, voffA);
            PG8_WAIT_L(8); PG8_BAR; PG8_WAIT_L(0); PG8_MMA(0, 0, At, B0); PG8_BAR; PG8_SCHED;
            PG8_LDB(B1, 1, 1); PG8_STAGE(PG8_SB(1, 0), b3, voffB);
            PG8_BAR; PG8_WAIT_L(0); PG8_MMA(0, 1, At, B1); PG8_BAR;
            PG8_LDA(At, 1, 1); PG8_STAGE(PG8_SA(1, 0), a3, voffA);
            PG8_BAR; PG8_WAIT_L(0); PG8_MMA(1, 0, At, B0); PG8_BAR; PG8_SCHED;
            PG8_STAGE(PG8_SB(1, 1), b3 + hstep, voffB);
            PG8_WAIT_V(6); PG8_BAR; PG8_MMA(1, 1, At, B1); PG8_BAR;
            }
        }
        if constexpr (FP8 != 0 && SP2) { if (has_next) PG8_STAGE(PG8_SA(1, 1), nA + kstep + hstep, voffA); }
        if constexpr (ALIGN_EPI) { if (wr == 0) PG8_BAR; }
        if constexpr (FP8 != 0) asm volatile("s_nop 15\n\ts_nop 15" ::: "memory");
        if constexpr (!Epi::AFTER_DRAIN) { E(acc, cur, wr, wc, fr, fq); S.done(cur); }
        if (!has_next) break;
#pragma unroll
        for (int a = 0; a < 2; ++a)
#pragma unroll
            for (int b = 0; b < 2; ++b)
#pragma unroll
                for (int m = 0; m < 4; ++m)
#pragma unroll
                    for (int n = 0; n < 2; ++n) acc[a][b][m][n] = (f32x4){0.f, 0.f, 0.f, 0.f};
        cur = nxt; cA = nA; cB = nB; ++ui;
        if constexpr (ALIGN_EPI) { if (wr == 1) PG8_BAR; }
    }
    PG8_WAIT_V(0);
    if constexpr (!ALIGN_EPI) { if (wr == 0) PG8_BAR; }
    PG8_BAR;
    if constexpr (Epi::AFTER_DRAIN) { E.fused(acc, cur, wr, wc, fr, fq, lds, wid, lane); S.done(cur); }
#undef PG8_SA
#undef PG8_SB
#undef PG8_STAGE
#undef PG8_LDA
#undef PG8_LDB
#undef PG8_MMA
#undef PG8_WAIT_V
#undef PG8_WAIT_V8F
#undef PG8_WAIT_L
#undef PG8_BAR
#undef PG8_SCHED
}
}

constexpr int NB = 8, SEQ = 2048, DM = 4096, MT = NB * SEQ;
constexpr int LDP = 26624;
constexpr int LDPS = 18432, S_RG = 6144, S_GA = 10240, S_GR = 14336;
constexpr int C_DAQ = 0, C_DAK = 2048, C_DAV = 4096, C_RQ = 6144, C_RK = 8192, C_RV = 10240, C_RG = 14336, C_GA = 18432, C_GR = 22528;
constexpr int NE = 16384;
constexpr float LN_EPS = 1e-5f;
constexpr float DN_ALPHA = 1.189207115002721f;
constexpr float LOG2E = 1.4426950408889634f;
#ifndef LDZ_PAD
#define LDZ_PAD 64
#endif
constexpr int LDZ = DM + LDZ_PAD;

namespace pg8 {
__device__ __forceinline__ void ld8bf(const bf16_t* p, float (&f)[8]) {
    const u32x4 w = *(const u32x4*)p;
    f[0] = __uint_as_float(w.x << 16); f[1] = __uint_as_float(w.x & 0xffff0000u); f[2] = __uint_as_float(w.y << 16); f[3] = __uint_as_float(w.y & 0xffff0000u);
    f[4] = __uint_as_float(w.z << 16); f[5] = __uint_as_float(w.z & 0xffff0000u); f[6] = __uint_as_float(w.w << 16); f[7] = __uint_as_float(w.w & 0xffff0000u);
}
__device__ __forceinline__ void st8bf(bf16_t* p, const float (&f)[8]) {
    u32x4 w; w.x = cvt_pk_bf16(f[0], f[1]); w.y = cvt_pk_bf16(f[2], f[3]); w.z = cvt_pk_bf16(f[4], f[5]); w.w = cvt_pk_bf16(f[6], f[7]);
    *(u32x4*)p = w;
}
__device__ __forceinline__ float sigmoidf_(float x) { return __builtin_amdgcn_rcpf(1.0f + __builtin_amdgcn_exp2f(-x * LOG2E)); }

__device__ __forceinline__ float clamp448(float x) { return fminf(fmaxf(x, -448.0f), 448.0f); }
__device__ __forceinline__ unsigned pk4_fp8(float a, float b, float c, float d) { int w = 0; w = __builtin_amdgcn_cvt_pk_fp8_f32(clamp448(a), clamp448(b), w, false); w = __builtin_amdgcn_cvt_pk_fp8_f32(clamp448(c), clamp448(d), w, true); return (unsigned)w; }
typedef unsigned u32x2 __attribute__((ext_vector_type(2)));
__device__ __forceinline__ void unpack8(const u32x4 w, float (&f)[8]) {
    f[0] = __uint_as_float(w.x << 16); f[1] = __uint_as_float(w.x & 0xffff0000u); f[2] = __uint_as_float(w.y << 16); f[3] = __uint_as_float(w.y & 0xffff0000u);
    f[4] = __uint_as_float(w.z << 16); f[5] = __uint_as_float(w.z & 0xffff0000u); f[6] = __uint_as_float(w.w << 16); f[7] = __uint_as_float(w.w & 0xffff0000u);
}
template <class Op> struct Epi8 {
    static constexpr bool PERM = true, AFTER_DRAIN = false; static constexpr int NVM = Op::NVM;
    Op op;
    template <int ST> __device__ __forceinline__ void stage(f32x4 (&acc)[2][2][4][2], int row0, int col0, unsigned& keep) const {
        if constexpr (sizeof(typename Op::Pre) <= 16) {
            typename Op::Pre pre[2][4][2];
#pragma unroll
            for (int ai = 0; ai < 2; ++ai)
#pragma unroll
                for (int m = 0; m < 4; ++m)
#pragma unroll
                    for (int bj = 0; bj < 2; ++bj) pre[ai][m][bj] = op.template pre<ST>(row0 + ai * HALF + m * 16, col0 + bj * HALF);
#pragma unroll
            for (int ai = 0; ai < 2; ++ai)
#pragma unroll
                for (int m = 0; m < 4; ++m)
#pragma unroll
                    for (int bj = 0; bj < 2; ++bj) {
                        f32x4& a = acc[ai][bj][m][0]; f32x4& b = acc[ai][bj][m][1];
                        float v[8] = {a[0], a[1], a[2], a[3], b[0], b[1], b[2], b[3]};
                        if (!op.template apply<ST>(v, pre[ai][m][bj])) keep &= ~(1u << (ai * 8 + m * 2 + bj));
                        a = (f32x4){v[0], v[1], v[2], v[3]}; b = (f32x4){v[4], v[5], v[6], v[7]};
                    }
        } else {
#pragma unroll
        for (int ai = 0; ai < 2; ++ai) {
            typename Op::Pre pre[4][2];
#pragma unroll
            for (int m = 0; m < 4; ++m)
#pragma unroll
                for (int bj = 0; bj < 2; ++bj) pre[m][bj] = op.template pre<ST>(row0 + ai * HALF + m * 16, col0 + bj * HALF);
#pragma unroll
            for (int m = 0; m < 4; ++m)
#pragma unroll
                for (int bj = 0; bj < 2; ++bj) {
                    f32x4& a = acc[ai][bj][m][0]; f32x4& b = acc[ai][bj][m][1];
                    float v[8] = {a[0], a[1], a[2], a[3], b[0], b[1], b[2], b[3]};
                    if (!op.template apply<ST>(v, pre[m][bj])) keep &= ~(1u << (ai * 8 + m * 2 + bj));
                    a = (f32x4){v[0], v[1], v[2], v[3]}; b = (f32x4){v[4], v[5], v[6], v[7]};
                }
            __builtin_amdgcn_sched_barrier(0);
        }
        }
    }
    __device__ __forceinline__ void operator()(f32x4 (&acc)[2][2][4][2], const Unit& u, int wr, int wc, int fr, int fq) const {
        const int row0 = u.pm * BM + wr * 64 + fr, col0 = u.pn * BM + wc * 32 + 8 * fq;
        unsigned keep = 0xffffu;
        if constexpr (Op::NST >= 1) stage<0>(acc, row0, col0, keep);
        if constexpr (Op::NST >= 2) stage<1>(acc, row0, col0, keep);
#pragma unroll
        for (int ai = 0; ai < 2; ++ai)
#pragma unroll
            for (int m = 0; m < 4; ++m)
#pragma unroll
                for (int bj = 0; bj < 2; ++bj) if (keep & (1u << (ai * 8 + m * 2 + bj))) {
                    const f32x4 a = acc[ai][bj][m][0], b = acc[ai][bj][m][1];
                    const float v[8] = {a[0], a[1], a[2], a[3], b[0], b[1], b[2], b[3]};
                    op.store(row0 + ai * HALF + m * 16, col0 + bj * HALF, v);
                }
    }
};
struct NoPre {};
struct OpStore { bf16_t* O; int ld; static constexpr int NVM = 16, NST = 0; typedef NoPre Pre;
    template <int ST> __device__ __forceinline__ Pre pre(int, int) const { return Pre{}; }
    template <int ST> __device__ __forceinline__ bool apply(float (&)[8], const Pre&) const { return true; }
    __device__ __forceinline__ void store(int row, int col, const float (&v)[8]) const { st8bf(O + (size_t)row * ld + col, v); } };
typedef float f32x16 __attribute__((ext_vector_type(16)));
typedef int v6i32e __attribute__((ext_vector_type(6)));
__device__ __forceinline__ void cvt_block_fp6(const float (&x)[32], u32x4& lo, u32x4& hi) {
    f32x16 a, b;
#pragma unroll
    for (int i = 0; i < 16; ++i) { a[i] = x[i]; b[i] = x[16 + i]; }
    const v6i32e r = __builtin_amdgcn_cvt_scalef32_2xpk16_fp6_f32(a, b, 1.0f);
    lo = (u32x4){(unsigned)r[0], (unsigned)r[1], (unsigned)r[2], (unsigned)r[3]}; hi = (u32x4){(unsigned)r[4], (unsigned)r[5], 0u, 0u};
}
struct OpStoreProj { bf16_t* O; bf16_t* O2; float s; static constexpr int NVM = 16, NST = 0; typedef NoPre Pre;
    template <int ST> __device__ __forceinline__ Pre pre(int, int) const { return Pre{}; }
    template <int ST> __device__ __forceinline__ bool apply(float (&)[8], const Pre&) const { return true; }
    __device__ __forceinline__ void store(int row, int col, const float (&v)[8]) const {
        const float f = s * ((col < C_DAK) ? (0.125f * LOG2E) : ((col >= C_RK && col < C_RV) ? 0.08838834764831845f : 1.0f));
        float w[8];
#pragma unroll
        for (int i = 0; i < 8; ++i) w[i] = v[i] * f;
        const unsigned seg = (((unsigned)(col - C_RQ) >> 7) << 14) + (unsigned)row;
        bf16_t* p = (col >= C_RQ && col < C_RG) ? O2 + ((size_t)seg * 128u + ((unsigned)col & 127u)) : O + ((size_t)row * LDPS + (col >= C_RG ? col - 8192 : col));
        st8bf(p, w); } };
struct OpNull { bf16_t* O; static constexpr int NVM = 0, NST = 0; typedef NoPre Pre;
    template <int ST> __device__ __forceinline__ Pre pre(int, int) const { return Pre{}; }
    template <int ST> __device__ __forceinline__ bool apply(float (&)[8], const Pre&) const { return true; }
    __device__ __forceinline__ void store(int row, int col, const float (&v)[8]) const { if (v[0] != v[0] && v[5] != v[5]) st8bf(O + (size_t)row * 8 + col, v); } };
struct OpStoreS { bf16_t* O; int ld; float s; static constexpr int NVM = 16, NST = 0; typedef NoPre Pre;
    template <int ST> __device__ __forceinline__ Pre pre(int, int) const { return Pre{}; }
    template <int ST> __device__ __forceinline__ bool apply(float (&)[8], const Pre&) const { return true; }
    __device__ __forceinline__ void store(int row, int col, const float (&v)[8]) const {
        float w[8];
#pragma unroll
        for (int i = 0; i < 8; ++i) w[i] = v[i] * s;
        st8bf(O + (size_t)row * ld + col, w); } };
struct OpGateA { const bf16_t* P; bf16_t* O; float s; static constexpr int NVM = 32, NST = 1; typedef u32x4 Pre;
    template <int ST> __device__ __forceinline__ Pre pre(int row, int col) const { return *(const u32x4*)(P + (size_t)row * LDPS + S_GA + col); }
    template <int ST> __device__ __forceinline__ bool apply(float (&v)[8], const Pre& pr) const {
        float g[8]; unpack8(pr, g);
#pragma unroll
        for (int i = 0; i < 8; ++i) v[i] *= s * sigmoidf_(g[i]);
        return true; }
    __device__ __forceinline__ void store(int row, int col, const float (&v)[8]) const { st8bf(O + (size_t)row * DM + col, v); } };
struct PreGO { u32x4 g, o; };
struct OpGateR { const bf16_t* P; const bf16_t* Oin; unsigned char* O8; float s, so; static constexpr int NVM = 48, NST = 1; typedef PreGO Pre;
    template <int ST> __device__ __forceinline__ Pre pre(int row, int col) const { Pre p; p.g = *(const u32x4*)(P + (size_t)row * LDPS + S_GR + col); p.o = *(const u32x4*)(Oin + (size_t)row * DM + col); return p; }
    template <int ST> __device__ __forceinline__ bool apply(float (&v)[8], const Pre& pr) const {
        float g[8], o[8]; unpack8(pr.g, g); unpack8(pr.o, o);
#pragma unroll
        for (int i = 0; i < 8; ++i) v[i] = (o[i] + v[i] * s * sigmoidf_(g[i])) * so;
        return true; }
    __device__ __forceinline__ void store(int row, int col, const float (&v)[8]) const {
        u32x2 w; w.x = pk4_fp8(v[0], v[1], v[2], v[3]); w.y = pk4_fp8(v[4], v[5], v[6], v[7]);
        *(u32x2*)(O8 + (size_t)row * DM + col) = w; } };
struct PreX { f32x4 x0, x1; };
struct OpResF32 { const float* X; bf16_t* O; float s; static constexpr int NVM = 48, NST = 1; typedef PreX Pre;
    template <int ST> __device__ __forceinline__ Pre pre(int row, int col) const { Pre p; p.x0 = *(const f32x4*)(X + (size_t)row * DM + col); p.x1 = *(const f32x4*)(X + (size_t)row * DM + col + 4); return p; }
    template <int ST> __device__ __forceinline__ bool apply(float (&v)[8], const Pre& pr) const {
        v[0] = v[0] * s + DN_ALPHA * pr.x0[0]; v[1] = v[1] * s + DN_ALPHA * pr.x0[1]; v[2] = v[2] * s + DN_ALPHA * pr.x0[2]; v[3] = v[3] * s + DN_ALPHA * pr.x0[3];
        v[4] = v[4] * s + DN_ALPHA * pr.x1[0]; v[5] = v[5] * s + DN_ALPHA * pr.x1[1]; v[6] = v[6] * s + DN_ALPHA * pr.x1[2]; v[7] = v[7] * s + DN_ALPHA * pr.x1[3];
        return true; }
    __device__ __forceinline__ void store(int row, int col, const float (&v)[8]) const { st8bf(O + (size_t)row * LDZ + col, v); } };
struct OpResF32NoStore { const float* X; bf16_t* O; float s; static constexpr int NVM = 0, NST = 1; typedef PreX Pre;
    template <int ST> __device__ __forceinline__ Pre pre(int row, int col) const { Pre p; p.x0 = *(const f32x4*)(X + (size_t)row * DM + col); p.x1 = *(const f32x4*)(X + (size_t)row * DM + col + 4); return p; }
    template <int ST> __device__ __forceinline__ bool apply(float (&v)[8], const Pre& pr) const { v[0] += pr.x0[0]; v[1] += pr.x0[1]; v[2] += pr.x0[2]; v[3] += pr.x0[3]; v[4] += pr.x1[0]; v[5] += pr.x1[1]; v[6] += pr.x1[2]; v[7] += pr.x1[3]; return true; }
    __device__ __forceinline__ void store(int row, int col, const float (&v)[8]) const { if (v[0] != v[0] && v[5] != v[5]) st8bf(O + (size_t)row * DM + col, v); } };
struct OpResF32NoLoad { const float* X; bf16_t* O; float s; static constexpr int NVM = 0, NST = 0; typedef NoPre Pre;
    template <int ST> __device__ __forceinline__ Pre pre(int, int) const { return Pre{}; }
    template <int ST> __device__ __forceinline__ bool apply(float (&)[8], const Pre&) const { return true; }
    __device__ __forceinline__ void store(int row, int col, const float (&v)[8]) const { st8bf(O + (size_t)row * DM + col, v); } };
struct OpPeerH8 { unsigned char* GA; float hs; static constexpr int NVM = 16, NST = 1; typedef u32x2 Pre;
    template <int ST> __device__ __forceinline__ Pre pre(int row, int col) const { return *(const u32x2*)(GA + (size_t)row * NE + col); }
    template <int ST> __device__ __forceinline__ bool apply(float (&v)[8], const Pre& w) const {
        if ((w.x | w.y) == 0u) return false;
        float g[8];
        g[0] = __builtin_amdgcn_cvt_f32_fp8((int)w.x, 0); g[1] = __builtin_amdgcn_cvt_f32_fp8((int)w.x, 1); g[2] = __builtin_amdgcn_cvt_f32_fp8((int)w.x, 2); g[3] = __builtin_amdgcn_cvt_f32_fp8((int)w.x, 3);
        g[4] = __builtin_amdgcn_cvt_f32_fp8((int)w.y, 0); g[5] = __builtin_amdgcn_cvt_f32_fp8((int)w.y, 1); g[6] = __builtin_amdgcn_cvt_f32_fp8((int)w.y, 2); g[7] = __builtin_amdgcn_cvt_f32_fp8((int)w.y, 3);
#pragma unroll
        for (int i = 0; i < 8; i += 2) { const f32x2 r = gelu_pk((f32x2){v[i] * hs, v[i + 1] * hs}); v[i] = r.x * g[i]; v[i + 1] = r.y * g[i + 1]; }
        return true; }
    __device__ __forceinline__ void store(int row, int col, const float (&v)[8]) const {
        u32x2 o; o.x = pk4_fp8(v[0], v[1], v[2], v[3]); o.y = pk4_fp8(v[4], v[5], v[6], v[7]);
        *(u32x2*)(GA + (size_t)row * NE + col) = o; } };
template <bool NOGELU> struct OpPeerH8Probe { const unsigned char* GA; unsigned char* GO; float hs; static constexpr int NVM = 0, NST = 1; typedef u32x2 Pre;
    template <int ST> __device__ __forceinline__ Pre pre(int row, int col) const { return *(const u32x2*)(GA + (size_t)row * NE + col); }
    template <int ST> __device__ __forceinline__ bool apply(float (&v)[8], const Pre& w) const {
        if ((w.x | w.y) == 0u) return false;
        float g[8];
        g[0] = __builtin_amdgcn_cvt_f32_fp8((int)w.x, 0); g[1] = __builtin_amdgcn_cvt_f32_fp8((int)w.x, 1); g[2] = __builtin_amdgcn_cvt_f32_fp8((int)w.x, 2); g[3] = __builtin_amdgcn_cvt_f32_fp8((int)w.x, 3);
        g[4] = __builtin_amdgcn_cvt_f32_fp8((int)w.y, 0); g[5] = __builtin_amdgcn_cvt_f32_fp8((int)w.y, 1); g[6] = __builtin_amdgcn_cvt_f32_fp8((int)w.y, 2); g[7] = __builtin_amdgcn_cvt_f32_fp8((int)w.y, 3);
#pragma unroll
        for (int i = 0; i < 8; i += 2) { if (NOGELU) { v[i] = v[i] * hs * g[i]; v[i + 1] = v[i + 1] * hs * g[i + 1]; } else { const f32x2 r = gelu_pk((f32x2){v[i] * hs, v[i + 1] * hs}); v[i] = r.x * g[i]; v[i + 1] = r.y * g[i + 1]; } }
        return true; }
    __device__ __forceinline__ void store(int row, int col, const float (&v)[8]) const {
        u32x2 o; o.x = pk4_fp8(v[0], v[1], v[2], v[3]); o.y = pk4_fp8(v[4], v[5], v[6], v[7]);
        *(u32x2*)(GO + (size_t)row * NE + col) = o; } };
struct OpResBfS { const bf16_t* X; bf16_t* O; float s; static constexpr int NVM = 32, NST = 1; typedef u32x4 Pre;
    template <int ST> __device__ __forceinline__ Pre pre(int row, int col) const { return *(const u32x4*)(X + (size_t)row * DM + col); }
    template <int ST> __device__ __forceinline__ bool apply(float (&v)[8], const Pre& pr) const {
        float x[8]; unpack8(pr, x);
#pragma unroll
        for (int i = 0; i < 8; ++i) v[i] = v[i] * s + DN_ALPHA * x[i];
        return true; }
    __device__ __forceinline__ void store(int row, int col, const float (&v)[8]) const { st8bf(O + (size_t)row * LDZ + col, v); } };
}

namespace mix {
typedef unsigned short bf16_t;
typedef short bf16x8 __attribute__((ext_vector_type(8)));
typedef short s16x4 __attribute__((ext_vector_type(4)));
typedef float f32x16 __attribute__((ext_vector_type(16)));
typedef unsigned u32x4 __attribute__((ext_vector_type(4)));
typedef float f32x4v __attribute__((ext_vector_type(4)));
#define MIX_LAS __attribute__((address_space(3)))
#ifndef MIX_PP
#define MIX_PP false
#endif
#ifndef MIX_PF
#define MIX_PF true
#endif
constexpr int KCS = 1040;
__device__ __forceinline__ constexpr int crow(int r, int hi) { return (r & 3) + 8 * (r >> 2) + 4 * hi; }
__device__ __forceinline__ unsigned voff_b(unsigned row, unsigned ch) { return 256u * row + 16u * (ch ^ (((row & 3u) << 2) | ((row >> 2) & 3u))); }
typedef float f32x2_t __attribute__((ext_vector_type(2))); typedef __bf16 bf16x2_t __attribute__((ext_vector_type(2)));
__device__ __forceinline__ unsigned pk_bf16(float lo, float hi) { const f32x2_t v = {lo, hi}; return __builtin_bit_cast(unsigned, __builtin_convertvector(v, bf16x2_t)); }
__device__ __forceinline__ float swapmax(float v) { auto rr = __builtin_amdgcn_permlane32_swap(__float_as_uint(v), __float_as_uint(v), false, false); return fmaxf(__uint_as_float(rr[0]), __uint_as_float(rr[1])); }
__device__ __forceinline__ float swapadd(float v) { auto rr = __builtin_amdgcn_permlane32_swap(__float_as_uint(v), __float_as_uint(v), false, false); return __uint_as_float(rr[0]) + __uint_as_float(rr[1]); }
template <int CTRL> __device__ __forceinline__ float dpp_add(float v) { return v + __uint_as_float(__builtin_amdgcn_update_dpp(0u, __float_as_uint(v), CTRL, 0xf, 0xf, true)); }
__device__ __forceinline__ float sum32(float v) {
    v = dpp_add<0xB1>(v); v = dpp_add<0x4E>(v);
    v = dpp_add<0x141>(v); v = dpp_add<0x140>(v);
    auto rr = __builtin_amdgcn_permlane16_swap(__float_as_uint(v), __float_as_uint(v), false, false);
    return __uint_as_float(rr[0]) + __uint_as_float(rr[1]);
}
template <int D, int NVIMG> struct Lay { static constexpr int KB = (D / 8) * KCS, VB = NVIMG * 16384, BUF = KB + VB; };

template <int D, bool SOFT>
__device__ __forceinline__ void tl_scores(const MIX_LAS unsigned char* kb, unsigned kaddr, const bf16x8 (&qf)[D / 16], int t, int qpos0, int qpos, int hi, int r32, float par,
                                          MIX_LAS float* wsf, f32x16 (&o)[4], float& m_run, float& l_run, u32x4 (&pw)[4]) {
    f32x16 p0, p1;
    const int kbase = 64 * t + 4 * hi;
    if (SOFT) {
        const float b0 = par * (float)(kbase - qpos);
#pragma unroll
        for (int r = 0; r < 16; ++r) { p0[r] = fmaf(par, (float)((r & 3) + 8 * (r >> 2)), b0); p1[r] = p0[r] + 32.0f * par; }
    } else {
#pragma unroll
        for (int r = 0; r < 16; ++r) { p0[r] = 0.f; p1[r] = 0.f; }
    }
#pragma unroll
    for (int d0 = 0; d0 < D / 16; ++d0) {
        const bf16x8 a0 = *(const MIX_LAS bf16x8*)(kb + kaddr + d0 * 2 * KCS);
        const bf16x8 a1 = *(const MIX_LAS bf16x8*)(kb + kaddr + d0 * 2 * KCS + 512);
        p0 = __builtin_amdgcn_mfma_f32_32x32x16_bf16(a0, qf[d0], p0, 0, 0, 0);
        p1 = __builtin_amdgcn_mfma_f32_32x32x16_bf16(a1, qf[d0], p1, 0, 0, 0);
        if (D > 64 && (d0 & 1)) __builtin_amdgcn_sched_barrier(0);
    }
    const bool needmask = (64 * t + 63 > qpos0);
    if (SOFT) {
        if (needmask) {
#pragma unroll
            for (int r = 0; r < 16; ++r) { const int kp = kbase + (r & 3) + 8 * (r >> 2); if (kp > qpos) p0[r] = -INFINITY; if (kp + 32 > qpos) p1[r] = -INFINITY; }
        }
        float mt = fmaxf(p0[0], p1[0]);
#pragma unroll
        for (int r = 1; r < 16; ++r) mt = fmaxf(mt, fmaxf(p0[r], p1[r]));
        mt = swapmax(mt);
        const float m_new = fmaxf(m_run, mt);
        if (__any(m_new > m_run)) {
            const float alpha = __builtin_amdgcn_exp2f(m_run - m_new);
            if (hi == 0) wsf[r32] = alpha;
            asm volatile("s_waitcnt lgkmcnt(0)" ::: "memory");
            l_run *= alpha; m_run = m_new;
#pragma unroll
            for (int r = 0; r < 16; ++r) { const float a = wsf[crow(r, hi)];
#pragma unroll
                for (int c = 0; c < 4; ++c) o[c][r] *= a; }
            asm volatile("s_waitcnt lgkmcnt(0)" ::: "memory");
        }
        float sacc = 0.f;
#pragma unroll
        for (int r = 0; r < 16; ++r) { p0[r] = __builtin_amdgcn_exp2f(p0[r] - m_run); p1[r] = __builtin_amdgcn_exp2f(p1[r] - m_run); sacc += p0[r] + p1[r]; }
        l_run += sacc;
    } else {
        const float rf0 = __builtin_amdgcn_exp2f(par * (float)(qpos - kbase)), rf1 = rf0 * __builtin_amdgcn_exp2f(-32.0f * par);
        float rb0[4], rb1[4];
#pragma unroll
        for (int i = 0; i < 4; ++i) { const float bq = __builtin_amdgcn_exp2f(-8.0f * par * (float)i); rb0[i] = rf0 * bq; rb1[i] = rf1 * bq; }
#pragma unroll
        for (int r = 0; r < 16; ++r) { const float ca = __builtin_amdgcn_exp2f(-par * (float)(r & 3)); p0[r] *= rb0[r >> 2] * ca; p1[r] *= rb1[r >> 2] * ca; }
        if (needmask) {
#pragma unroll
            for (int r = 0; r < 16; ++r) { const int kp = kbase + (r & 3) + 8 * (r >> 2); if (kp > qpos) p0[r] = 0.f; if (kp + 32 > qpos) p1[r] = 0.f; }
        }
    }
#pragma unroll
    for (int j = 0; j < 4; ++j) { pw[0][j] = pk_bf16(p0[2 * j], p0[2 * j + 1]); pw[1][j] = pk_bf16(p0[8 + 2 * j], p0[9 + 2 * j]);
                                  pw[2][j] = pk_bf16(p1[2 * j], p1[2 * j + 1]); pw[3][j] = pk_bf16(p1[8 + 2 * j], p1[9 + 2 * j]); }
}
__device__ __forceinline__ void tl_pv(const MIX_LAS unsigned char* vb, const unsigned (&vaddr)[4][2], const u32x4 (&pw)[4], f32x16 (&o)[4]) {
#pragma unroll
    for (int c = 0; c < 4; ++c) {
        s16x4 lo[4], hh[4];
#pragma unroll
        for (int ks = 0; ks < 4; ++ks) {
            lo[ks] = __builtin_amdgcn_ds_read_tr16_b64_v4i16((MIX_LAS s16x4*)(vb + vaddr[c][0] + 4096 * ks));
            hh[ks] = __builtin_amdgcn_ds_read_tr16_b64_v4i16((MIX_LAS s16x4*)(vb + vaddr[c][1] + 4096 * ks));
        }
#pragma unroll
        for (int ks = 0; ks < 4; ++ks) {
            const bf16x8 vf = (bf16x8){lo[ks][0], lo[ks][1], lo[ks][2], lo[ks][3], hh[ks][0], hh[ks][1], hh[ks][2], hh[ks][3]};
            o[c] = __builtin_amdgcn_mfma_f32_32x32x16_bf16(__builtin_bit_cast(bf16x8, pw[ks]), vf, o[c], 0, 0, 0);
        }
        __builtin_amdgcn_sched_barrier(0);
    }
}

template <int D, int NVIMG, bool SOFT, bool PP, bool PF = false, int VAR = 0>
__device__ __forceinline__ void tile_loop(MIX_LAS unsigned char* lds, MIX_LAS float* wsf, const bf16_t* Qg, const bf16_t* Kg, const bf16_t* Vg,
                                          int qpos0, int vimg, int t0, int nt, float par, f32x16 (&o)[4], float& m_run, float& l_run) {
    typedef Lay<D, NVIMG> L;
    int tid = threadIdx.x; asm volatile("" : "+v"(tid));
    const int lane = tid & 63, r32 = lane & 31, hi = lane >> 5;
    constexpr int NKL = D / 64, NVL = 2 * NVIMG, CPK = D / 8;
    bf16x8 qf[D / 16];
#pragma unroll
    for (int d0 = 0; d0 < D / 16; ++d0) qf[d0] = *(const bf16x8*)(Qg + (size_t)(qpos0 + r32) * LDPS + d0 * 16 + hi * 8);
    const int qpos = qpos0 + r32;
    unsigned kgo[NKL], klo[NKL], vgo[NVL], vlo[NVL];
#pragma unroll
    for (int i = 0; i < NKL; ++i) { const int idx = tid + 512 * i, ch = idx % CPK, key = idx / CPK; kgo[i] = (unsigned)(key * LDPS + ch * 8) * 2u; klo[i] = (unsigned)(ch * KCS + key * 16); }
#pragma unroll
    for (int i = 0; i < NVL; ++i) { const int idx = tid + 512 * i, im = idx >> 10, key = (idx & 1023) >> 4, ch = idx & 15; vgo[i] = (unsigned)(key * LDPS + im * 128 + ch * 8) * 2u; vlo[i] = (unsigned)(L::KB + im * 16384) + voff_b(key, ch); }
    u32x4 kst[NKL], vst[NVL];
    constexpr size_t TSTEP = (size_t)64 * LDPS * 2;
#define MIX_LOADK(t_) do { const char* kt_ = (const char*)Kg + (size_t)(t_) * TSTEP; _Pragma("unroll") for (int i = 0; i < NKL; ++i) kst[i] = *(const u32x4*)(kt_ + kgo[i]); } while (0)
#define MIX_LOADV(t_) do { const char* vt_ = (const char*)Vg + (size_t)(t_) * TSTEP; _Pragma("unroll") for (int i = 0; i < NVL; ++i) vst[i] = *(const u32x4*)(vt_ + vgo[i]); } while (0)
#define MIX_STOREK(b_) do { MIX_LAS unsigned char* bb = lds + (b_) * L::BUF; _Pragma("unroll") for (int i = 0; i < NKL; ++i) *(MIX_LAS u32x4*)(bb + klo[i]) = kst[i]; } while (0)
#define MIX_STOREV(b_) do { MIX_LAS unsigned char* bb = lds + (b_) * L::BUF; _Pragma("unroll") for (int i = 0; i < NVL; ++i) *(MIX_LAS u32x4*)(bb + vlo[i]) = vst[i]; } while (0)
    const unsigned tq = (lane & 15) >> 2, tp = lane & 3, tblk = (lane >> 4) & 1;
    unsigned vaddr[4][2];
#pragma unroll
    for (int c = 0; c < 4; ++c)
#pragma unroll
        for (int tt = 0; tt < 2; ++tt) vaddr[c][tt] = voff_b(8u * tt + 4u * hi + tq, 4u * c + 2u * tblk + (tp >> 1)) + 8u * (tp & 1u);
    const unsigned kaddr = (unsigned)(hi * KCS + r32 * 16);
    u32x4 pw[4] = {};
    MIX_LOADK(t0); MIX_LOADV(t0); MIX_STOREK(t0 & 1); MIX_STOREV(t0 & 1); __syncthreads();
    if constexpr (PP) {
        const bool lag = (__builtin_amdgcn_readfirstlane(tid >> 6) >= 4);
        const int tend = t0 + nt;
        for (int iv = 0; iv < 2 * nt + 2; ++iv) {
            const int t = t0 + (iv >> 1); const bool odd = (iv & 1) != 0;
            const bool more = (t + 1 < tend);
            if (more) { if (!odd) { MIX_LOADK(t + 1); MIX_LOADV(t + 1); } else { MIX_STOREK((t + 1) & 1); MIX_STOREV((t + 1) & 1); } }
            const int tb = lag ? t - 1 : t;
            const bool doB = (lag != odd) && (tb >= t0) && (tb < tend) && (64 * tb <= qpos0 + 31);
            const bool doA = (lag == odd) && (t < tend) && (64 * t <= qpos0 + 31);
            if (doB) tl_pv(lds + (tb & 1) * L::BUF + L::KB + vimg * 16384, vaddr, pw, o);
            if (doA) tl_scores<D, SOFT>(lds + (t & 1) * L::BUF, kaddr, qf, t, qpos0, qpos, hi, r32, par, wsf, o, m_run, l_run, pw);
            __syncthreads();
        }
    } else if constexpr (PF) {
        const int tend = t0 + nt;
        if (nt > 1) { MIX_LOADK(t0 + 1); MIX_LOADV(t0 + 1); }
        for (int t = t0; t < tend; ++t) {
            const bool active = (64 * t <= qpos0 + 31);
            if (t + 1 < tend) { MIX_STOREK((t + 1) & 1); MIX_STOREV((t + 1) & 1); }
            if (t + 2 < tend) { MIX_LOADK(t + 2); MIX_LOADV(t + 2); }
            const MIX_LAS unsigned char* kb = lds + (t & 1) * L::BUF;
            if (active) { if (VAR < 2) tl_scores<D, SOFT>(kb, kaddr, qf, t, qpos0, qpos, hi, r32, par, wsf, o, m_run, l_run, pw); if (VAR < 1) tl_pv(kb + L::KB + vimg * 16384, vaddr, pw, o); }
            asm volatile("s_waitcnt lgkmcnt(0)\n\ts_barrier" ::: "memory");
        }
    } else {
        for (int t = t0; t < t0 + nt; ++t) {
            const bool more = (t + 1 < t0 + nt);
            const bool active = (64 * t <= qpos0 + 31);
            if (more) MIX_LOADV(t + 1);
            const MIX_LAS unsigned char* kb = lds + (t & 1) * L::BUF;
            if (active) tl_scores<D, SOFT>(kb, kaddr, qf, t, qpos0, qpos, hi, r32, par, wsf, o, m_run, l_run, pw);
            if (more) { MIX_STOREV((t + 1) & 1); MIX_LOADK(t + 1); }
            if (active) tl_pv(kb + L::KB + vimg * 16384, vaddr, pw, o);
            if (more) MIX_STOREK((t + 1) & 1);
            __syncthreads();
        }
    }
#undef MIX_LOADK
#undef MIX_LOADV
#undef MIX_STOREK
#undef MIX_STOREV
}

constexpr float ATT_SCALE = 8.0f, RET_SCALE = 8.0f;
struct MixArgs { const bf16_t* P; unsigned char* atto; unsigned char* reto; bf16_t* state;
  const float* lam_p; const float* subln_w; const float* gn_w; const float* gn_b; };
template <int VAR = 0> __device__ __forceinline__ void attn_unit(MIX_LAS unsigned char* lds, const MixArgs& A, int b, int h, int qb) {
    typedef Lay<64, 1> L;
    const int tid = threadIdx.x, lane = tid & 63, r32 = lane & 31, hi = lane >> 5, wave = __builtin_amdgcn_readfirstlane(tid >> 6);
    MIX_LAS float* wsf = (MIX_LAS float*)(lds + 2 * L::BUF) + wave * 64;
    float lam;
    { const float a = A.lam_p[lane] * A.lam_p[64 + lane], c = A.lam_p[128 + lane] * A.lam_p[192 + lane];
      float sa = a, sc = c;
#pragma unroll
      for (int o_ = 1; o_ < 64; o_ <<= 1) { sa += __shfl_xor(sa, o_); sc += __shfl_xor(sc, o_); }
      lam = __expf(sa) - __expf(sc) + 0.2f; }
    const float sl2 = exp2f(-0.5f * (float)(h + 1)) * LOG2E;
    const int qpos0 = qb * 256 + wave * 32, nt = 4 * (qb + 1);
    const bf16_t* base = A.P + (size_t)b * SEQ * LDPS;
    const bf16_t* Vg = base + C_DAV + h * 128;
    MIX_LAS unsigned* stash = (MIX_LAS unsigned*)(lds + 2 * L::BUF + 8 * 256) + wave * 2048 + lane;
    f32x16 o[4];
#pragma unroll
    for (int mp = 0; mp < 2; ++mp) {
        const bf16_t* Qg = base + C_DAQ + h * 128 + mp * 64; const bf16_t* Kg = base + C_DAK + h * 128 + mp * 64;
#pragma unroll
        for (int c = 0; c < 4; ++c)
#pragma unroll
            for (int r = 0; r < 16; ++r) o[c][r] = 0.f;
        float m_run = -INFINITY, l_run = 0.f;
        tile_loop<64, 1, true, MIX_PP, MIX_PF, VAR>(lds, wsf, Qg, Kg, Vg, qpos0, 0, 0, (VAR == 3) ? 1 : nt, sl2, o, m_run, l_run);
        const float inv = __builtin_amdgcn_rcpf(swapadd(l_run));
        if (hi == 0) wsf[r32] = inv;
        asm volatile("s_waitcnt lgkmcnt(0)" ::: "memory");
#pragma unroll
        for (int r = 0; r < 16; ++r) { const float a = wsf[crow(r, hi)];
#pragma unroll
            for (int c = 0; c < 4; ++c) o[c][r] *= a; }
        asm volatile("s_waitcnt lgkmcnt(0)" ::: "memory");
        if (mp == 0) {
#pragma unroll
            for (int c = 0; c < 4; ++c)
#pragma unroll
                for (int j = 0; j < 8; ++j) stash[64 * (c * 8 + j)] = pk_bf16(o[c][2 * j], o[c][2 * j + 1]);
        }
    }
    int r32e = r32, hie = hi; asm volatile("" : "+v"(r32e), "+v"(hie));
    float ss[16];
#pragma unroll
    for (int r = 0; r < 16; ++r) ss[r] = 0.f;
#pragma unroll
    for (int c = 0; c < 4; ++c)
#pragma unroll
        for (int j = 0; j < 8; ++j) {
            const unsigned sv = stash[64 * (c * 8 + j)]; const float a0 = __uint_as_float(sv << 16), a1 = __uint_as_float(sv & 0xffff0000u);
            o[c][2 * j] = a0 - lam * o[c][2 * j]; o[c][2 * j + 1] = a1 - lam * o[c][2 * j + 1];
            ss[2 * j] += o[c][2 * j] * o[c][2 * j]; ss[2 * j + 1] += o[c][2 * j + 1] * o[c][2 * j + 1];
        }
    float sw[4];
#pragma unroll
    for (int c = 0; c < 4; ++c) sw[c] = A.subln_w[32 * c + r32e] * (0.8f * ATT_SCALE);
    __syncthreads();
    MIX_LAS float* stg = (MIX_LAS float*)(lds + wave * 16384);
#pragma unroll
    for (int r = 0; r < 16; ++r) {
        const float rs = rsqrtf(sum32(ss[r]) * (1.0f / 128.0f) + LN_EPS);
#pragma unroll
        for (int c = 0; c < 4; ++c) stg[crow(r, hie) * 128 + 32 * c + r32e] = o[c][r] * rs * sw[c];
    }
    asm volatile("s_waitcnt lgkmcnt(0)" ::: "memory");
    unsigned char* obase = A.atto + (size_t)(b * SEQ + qpos0) * 2048 + h * 128;
#pragma unroll
    for (int i = 0; i < 8; ++i) {
        const int row = 4 * i + (lane >> 4), vg = lane & 15;
        const f32x4v x0 = *(const MIX_LAS f32x4v*)(stg + row * 128 + vg * 8), x1 = *(const MIX_LAS f32x4v*)(stg + row * 128 + vg * 8 + 4);
        pg8::u32x2 w; w.x = pg8::pk4_fp8(x0[0], x0[1], x0[2], x0[3]); w.y = pg8::pk4_fp8(x1[0], x1[1], x1[2], x1[3]);
        *(pg8::u32x2*)(obase + (size_t)row * 2048 + vg * 8) = w;
    }
    __syncthreads();
}

__device__ __forceinline__ void ret_state_unit(MIX_LAS unsigned char* lds, const MixArgs& A, int b, int h, int vs) {
    int tid = threadIdx.x; asm volatile("" : "+v"(tid));
    const int lane = tid & 63, r32 = lane & 31, hi = lane >> 5, wave = __builtin_amdgcn_readfirstlane(tid >> 6);
    const int db = wave >> 1, vh = wave & 1;
    const float lg2 = log2f(1.0f - exp2f(-5.0f - (float)h));
    const float g128 = exp2f(128.0f * lg2);
    const bf16_t* base = A.P + (size_t)b * SEQ * LDP;
    const char* Kg = (const char*)(base + C_RK + h * 128); const char* Vg = (const char*)(base + C_RV + h * 256 + vs * 128);
    unsigned go[4], lo_[4]; float kf[4];
#pragma unroll
    for (int i = 0; i < 4; ++i) { const int idx = tid + 512 * i, key = idx >> 4, ch = idx & 15; go[i] = (unsigned)(key * LDP + ch * 8) * 2u; lo_[i] = (unsigned)((key >> 6) * 16384) + voff_b(key & 63, ch); kf[i] = exp2f(lg2 * (float)(127 - key)); }
    constexpr size_t CSTEP = (size_t)128 * LDP * 2;
    u32x4 kst[4], vst[4];
#define RS_LOAD(c_) do { const char* kc_ = Kg + (size_t)(c_) * CSTEP; const char* vc_ = Vg + (size_t)(c_) * CSTEP; \
        _Pragma("unroll") for (int i = 0; i < 4; ++i) { kst[i] = *(const u32x4*)(kc_ + go[i]); vst[i] = *(const u32x4*)(vc_ + go[i]); } } while (0)
#define RS_STORE(b_) do { MIX_LAS unsigned char* bb = lds + (b_) * 65536; \
        _Pragma("unroll") for (int i = 0; i < 4; ++i) { u32x4 w; const float f = kf[i]; \
            w.x = pk_bf16(__uint_as_float(kst[i].x << 16) * f, __uint_as_float(kst[i].x & 0xffff0000u) * f); w.y = pk_bf16(__uint_as_float(kst[i].y << 16) * f, __uint_as_float(kst[i].y & 0xffff0000u) * f); \
            w.z = pk_bf16(__uint_as_float(kst[i].z << 16) * f, __uint_as_float(kst[i].z & 0xffff0000u) * f); w.w = pk_bf16(__uint_as_float(kst[i].w << 16) * f, __uint_as_float(kst[i].w & 0xffff0000u) * f); \
            *(MIX_LAS u32x4*)(bb + lo_[i]) = w; *(MIX_LAS u32x4*)(bb + 32768 + lo_[i]) = vst[i]; } } while (0)
    const unsigned tq = (lane & 15) >> 2, tp = lane & 3, tblk = (lane >> 4) & 1;
    unsigned ka[2], va[2][2];
#pragma unroll
    for (int tt = 0; tt < 2; ++tt) { ka[tt] = voff_b(8u * hi + 4u * tt + tq, 4u * db + 2u * tblk + (tp >> 1)) + 8u * (tp & 1u);
#pragma unroll
        for (int cc = 0; cc < 2; ++cc) va[cc][tt] = voff_b(8u * hi + 4u * tt + tq, 4u * (2 * vh + cc) + 2u * tblk + (tp >> 1)) + 8u * (tp & 1u); }
    f32x16 acc[2];
#pragma unroll
    for (int cc = 0; cc < 2; ++cc)
#pragma unroll
        for (int r = 0; r < 16; ++r) acc[cc][r] = 0.f;
    RS_LOAD(0); RS_STORE(0); __syncthreads();
    for (int c = 0; c < 15; ++c) {
        if (c + 1 < 15) RS_LOAD(c + 1);
        const MIX_LAS unsigned char* kb = lds + (c & 1) * 65536;
#pragma unroll
        for (int cc = 0; cc < 2; ++cc)
#pragma unroll
            for (int r = 0; r < 16; ++r) acc[cc][r] *= g128;
#pragma unroll
        for (int ks = 0; ks < 8; ++ks) {
            const MIX_LAS unsigned char* ki = kb + (ks >> 2) * 16384 + (ks & 3) * 4096; const MIX_LAS unsigned char* vi = ki + 32768;
            const s16x4 a0 = __builtin_amdgcn_ds_read_tr16_b64_v4i16((MIX_LAS s16x4*)(ki + ka[0])), a1 = __builtin_amdgcn_ds_read_tr16_b64_v4i16((MIX_LAS s16x4*)(ki + ka[1]));
            const bf16x8 af = (bf16x8){a0[0], a0[1], a0[2], a0[3], a1[0], a1[1], a1[2], a1[3]};
#pragma unroll
            for (int cc = 0; cc < 2; ++cc) {
                const s16x4 b0 = __builtin_amdgcn_ds_read_tr16_b64_v4i16((MIX_LAS s16x4*)(vi + va[cc][0])), b1 = __builtin_amdgcn_ds_read_tr16_b64_v4i16((MIX_LAS s16x4*)(vi + va[cc][1]));
                const bf16x8 bfr = (bf16x8){b0[0], b0[1], b0[2], b0[3], b1[0], b1[1], b1[2], b1[3]};
                acc[cc] = __builtin_amdgcn_mfma_f32_32x32x16_bf16(af, bfr, acc[cc], 0, 0, 0);
            }
        }
        bf16_t* so = A.state + ((size_t)((b * 16 + h) * 16 + c + 1) * 128 + 32 * db) * 256 + 128 * vs + 64 * vh + r32;
#pragma unroll
        for (int cc = 0; cc < 2; ++cc)
#pragma unroll
            for (int r = 0; r < 16; ++r) so[(size_t)crow(r, hi) * 256 + 32 * cc] = (bf16_t)(pk_bf16(acc[cc][r], 0.f) & 0xffffu);
        if (c + 1 < 15) RS_STORE((c + 1) & 1);
        asm volatile("s_waitcnt lgkmcnt(0)\n\ts_barrier" ::: "memory");
    }
    __syncthreads();
#undef RS_LOAD
#undef RS_STORE
}

__device__ __forceinline__ void ret_unit(MIX_LAS unsigned char* lds, const MixArgs& A, int b, int h, int qb) {
    typedef Lay<128, 2> L;
    int tid = threadIdx.x; asm volatile("" : "+v"(tid));
    const int lane = tid & 63, r32 = lane & 31, hi = lane >> 5, wave = __builtin_amdgcn_readfirstlane(tid >> 6);
    const int rg = wave >> 1, vh = wave & 1;
    MIX_LAS float* wsf = (MIX_LAS float*)(lds + 2 * L::BUF) + wave * 64;
    MIX_LAS float* stats = (MIX_LAS float*)(lds + 132096);
    const float lg2 = log2f(1.0f - exp2f(-5.0f - (float)h));
    const int qpos0 = qb * 128 + rg * 32;
    const bf16_t* base = A.P + (size_t)b * SEQ * LDP;
    f32x16 o[4];
#pragma unroll
    for (int c = 0; c < 4; ++c)
#pragma unroll
        for (int r = 0; r < 16; ++r) o[c][r] = 0.f;
    if (qb > 0) {
        const char* Sg = (const char*)(A.state + (size_t)((b * 16 + h) * 16 + qb) * 128 * 256);
        u32x4 st[8];
#pragma unroll
        for (int i = 0; i < 8; ++i) { const int idx = tid + 512 * i, t = idx >> 11, im = (idx >> 10) & 1, row = (idx & 1023) >> 4, ch = idx & 15;
            st[i] = *(const u32x4*)(Sg + ((size_t)(t * 64 + row) * 256 + im * 128 + ch * 8) * 2); }
#pragma unroll
        for (int i = 0; i < 8; ++i) { const int idx = tid + 512 * i, t = idx >> 11, im = (idx >> 10) & 1, row = (idx & 1023) >> 4, ch = idx & 15;
            *(MIX_LAS u32x4*)(lds + t * L::BUF + L::KB + im * 16384 + voff_b(row, ch)) = st[i]; }
        bf16x8 qa[8];
#pragma unroll
        for (int d0 = 0; d0 < 8; ++d0) qa[d0] = *(const bf16x8*)(base + (size_t)(qpos0 + r32) * LDP + C_RQ + h * 128 + d0 * 16 + hi * 8);
        __syncthreads();
        const unsigned tq = (lane & 15) >> 2, tp = lane & 3, tblk = (lane >> 4) & 1;
        unsigned vn[4][2];
#pragma unroll
        for (int c = 0; c < 4; ++c)
#pragma unroll
            for (int tt = 0; tt < 2; ++tt) vn[c][tt] = voff_b(8u * hi + 4u * tt + tq, 4u * c + 2u * tblk + (tp >> 1)) + 8u * (tp & 1u);
#pragma unroll
        for (int t = 0; t < 2; ++t) {
            const MIX_LAS unsigned char* vb = lds + t * L::BUF + L::KB + vh * 16384;
#pragma unroll
            for (int c = 0; c < 4; ++c) {
                s16x4 lo[4], hh[4];
#pragma unroll
                for (int ks = 0; ks < 4; ++ks) {
                    lo[ks] = __builtin_amdgcn_ds_read_tr16_b64_v4i16((MIX_LAS s16x4*)(vb + vn[c][0] + 4096 * ks));
                    hh[ks] = __builtin_amdgcn_ds_read_tr16_b64_v4i16((MIX_LAS s16x4*)(vb + vn[c][1] + 4096 * ks));
                }
#pragma unroll
                for (int ks = 0; ks < 4; ++ks) {
                    const bf16x8 vf = (bf16x8){lo[ks][0], lo[ks][1], lo[ks][2], lo[ks][3], hh[ks][0], hh[ks][1], hh[ks][2], hh[ks][3]};
                    o[c] = __builtin_amdgcn_mfma_f32_32x32x16_bf16(qa[4 * t + ks], vf, o[c], 0, 0, 0);
                }
                __builtin_amdgcn_sched_barrier(0);
            }
        }
#pragma unroll
        for (int r = 0; r < 16; ++r) { const float f = __builtin_amdgcn_exp2f(lg2 * (float)(rg * 32 + crow(r, hi) + 1));
#pragma unroll
            for (int c = 0; c < 4; ++c) o[c][r] *= f; }
        __syncthreads();
    }
    float m_run = 0.f, l_run = 0.f;
    tile_loop<128, 2, false, false>(lds, wsf, base + C_RQ + h * 128, base + C_RK + h * 128, base + C_RV + h * 256, qpos0, vh, 2 * qb, 2, lg2, o, m_run, l_run);
    int r32e = r32, hie = hi; asm volatile("" : "+v"(r32e), "+v"(hie));
#pragma unroll
    for (int r = 0; r < 16; ++r) {
        float s1 = 0.f, s2 = 0.f;
#pragma unroll
        for (int c = 0; c < 4; ++c) { s1 += o[c][r]; s2 += o[c][r] * o[c][r]; }
        s1 = sum32(s1); s2 = sum32(s2);
        if (r32e == 0) { stats[((rg * 2 + vh) * 32 + crow(r, hie)) * 2] = s1; stats[((rg * 2 + vh) * 32 + crow(r, hie)) * 2 + 1] = s2; }
    }
    MIX_LAS float* stg = (MIX_LAS float*)(lds + wave * 16384);
#pragma unroll
    for (int r = 0; r < 16; ++r)
#pragma unroll
        for (int c = 0; c < 4; ++c) stg[crow(r, hie) * 128 + 32 * c + r32e] = o[c][r];
    __syncthreads();
    const int vg = lane & 15, colb = h * 256 + vh * 128 + vg * 8;
    const f32x4v gw0 = *(const f32x4v*)(A.gn_w + colb), gw1 = *(const f32x4v*)(A.gn_w + colb + 4), gb0 = *(const f32x4v*)(A.gn_b + colb), gb1 = *(const f32x4v*)(A.gn_b + colb + 4);
    const size_t tok0 = (size_t)b * SEQ + qpos0;
#pragma unroll
    for (int i = 0; i < 8; ++i) {
        const int q = 4 * i + (lane >> 4);
        const u32x4 gq = *(const u32x4*)(A.P + (tok0 + q) * LDP + C_RG + colb);
        const float s1 = stats[((rg * 2 + 0) * 32 + q) * 2] + stats[((rg * 2 + 1) * 32 + q) * 2], s2 = stats[((rg * 2 + 0) * 32 + q) * 2 + 1] + stats[((rg * 2 + 1) * 32 + q) * 2 + 1];
        const float mu = s1 * (1.0f / 256.0f), var = fmaxf(s2 * (1.0f / 256.0f) - mu * mu, 0.f), rs = rsqrtf(var + LN_EPS);
        const f32x4v x0 = *(const MIX_LAS f32x4v*)(stg + q * 128 + vg * 8), x1 = *(const MIX_LAS f32x4v*)(stg + q * 128 + vg * 8 + 4);
        float g[8] = {__uint_as_float(gq.x << 16), __uint_as_float(gq.x & 0xffff0000u), __uint_as_float(gq.y << 16), __uint_as_float(gq.y & 0xffff0000u),
                      __uint_as_float(gq.z << 16), __uint_as_float(gq.z & 0xffff0000u), __uint_as_float(gq.w << 16), __uint_as_float(gq.w & 0xffff0000u)};
        float y[8];
#pragma unroll
        for (int j = 0; j < 4; ++j) { y[j] = (x0[j] - mu) * rs * gw0[j] + gb0[j]; y[4 + j] = (x1[j] - mu) * rs * gw1[j] + gb1[j]; }
#pragma unroll
        for (int j = 0; j < 8; ++j) y[j] *= RET_SCALE * g[j] * __builtin_amdgcn_rcpf(1.0f + __builtin_amdgcn_exp2f(-g[j] * LOG2E));
        pg8::u32x2 w; w.x = pg8::pk4_fp8(y[0], y[1], y[2], y[3]); w.y = pg8::pk4_fp8(y[4], y[5], y[6], y[7]);
        *(pg8::u32x2*)(A.reto + (tok0 + q) * 4096 + colb) = w;
    }
    __syncthreads();
}

#ifndef RFX_NO_CROSS
#define RFX_NO_CROSS 0
#endif
#ifndef RFX_NO_INTRA
#define RFX_NO_INTRA 0
#endif
#ifndef RFX_NO_UPD
#define RFX_NO_UPD 0
#endif
#ifndef RFX_NO_OUT
#define RFX_NO_OUT 0
#endif
template <int ABL = 0> __device__ __forceinline__ void ret_fused_unit(MIX_LAS unsigned char* lds, const MixArgs& A, const bf16_t* rqkv, bf16_t* raw, float* stats, int b, int h, int vh) {
    constexpr size_t MT_ROWS = 16384;
    int tid = threadIdx.x; asm volatile("" : "+v"(tid));
    const int lane = tid & 63, r32 = lane & 31, hi = lane >> 5, wave = __builtin_amdgcn_readfirstlane(tid >> 6);
    const int rg = wave >> 1, vq = wave & 1;
    const float lg2 = log2f(1.0f - exp2f(-5.0f - (float)h)), g128 = exp2f(128.0f * lg2);
    unsigned gs[4]; gs[0] = 0x3f800000u;
#pragma unroll
    for (int q = 1; q < 4; ++q) gs[q] = __builtin_amdgcn_readfirstlane(__float_as_uint(exp2f((float)q * lg2)));
    const unsigned gs8 = __builtin_amdgcn_readfirstlane(__float_as_uint(exp2f(8.0f * lg2)));
    const char* Qg = (const char*)(rqkv + ((size_t)(h) * MT_ROWS + (size_t)b * SEQ) * 128); const char* Kg = (const char*)(rqkv + ((size_t)(16 + h) * MT_ROWS + (size_t)b * SEQ) * 128);
    const char* Vg = (const char*)(rqkv + ((size_t)(32 + 2 * h + vh) * MT_ROWS + (size_t)b * SEQ) * 128);
    constexpr int KIMG = 0, VIMG = 32768, SIMG = 65536, OIMG = 98304;
    const unsigned go0 = (unsigned)((tid >> 4) * 128 + (tid & 15) * 8) * 2u, lo0 = voff_b((unsigned)(tid >> 4), (unsigned)(tid & 15));
    constexpr size_t GSTEP = (size_t)32 * 128 * 2;
    constexpr size_t CSTEP = (size_t)128 * 128 * 2;
    u32x4 kst[4], vst[4];
#define RF_LOAD(c_) do { const size_t o_ = (size_t)(c_) * CSTEP; _Pragma("unroll") for (int i = 0; i < 4; ++i) { kst[i] = *(const u32x4*)(Kg + (o_ + i * GSTEP) + go0); vst[i] = *(const u32x4*)(Vg + (o_ + i * GSTEP) + go0); } } while (0)
#define RF_STORE() do { float kf_ = __builtin_amdgcn_exp2f(lg2c * (float)(127 - (tidc >> 4))); const float kstep_ = __builtin_amdgcn_exp2f(-32.0f * lg2c); \
        _Pragma("unroll") for (int i = 0; i < 4; ++i) { u32x4 kw_; \
            _Pragma("unroll") for (int q_ = 0; q_ < 4; ++q_) kw_[q_] = pk_bf16(__uint_as_float(kst[i][q_] << 16) * kf_, __uint_as_float(kst[i][q_] & 0xffff0000u) * kf_); \
            *(MIX_LAS u32x4*)(lds + KIMG + 8192 * i + lo0) = kw_; *(MIX_LAS u32x4*)(lds + VIMG + 8192 * i + lo0) = vst[i]; kf_ *= kstep_; } } while (0)
#define RF_LOADQ(c_) do { const char* qp_ = Qg + (size_t)(c_) * CSTEP + (size_t)(32 * rg + r32) * 128 * 2 + hi * 16; _Pragma("unroll") for (int d0 = 0; d0 < 8; ++d0) qf[d0] = *(const bf16x8*)(qp_ + d0 * 32); } while (0)
#define RF_BAR() asm volatile("s_waitcnt lgkmcnt(0)\n\ts_barrier" ::: "memory")
    const unsigned tq = (lane & 15) >> 2, tp = lane & 3, tblk = (lane >> 4) & 1;
    unsigned vperm[2][2], vnat[2][2], knat[2];
#pragma unroll
    for (int tt = 0; tt < 2; ++tt) {
        knat[tt] = voff_b(8u * hi + 4u * tt + tq, 4u * rg + 2u * tblk + (tp >> 1)) + 8u * (tp & 1u);
#pragma unroll
        for (int cc = 0; cc < 2; ++cc) {
            vperm[cc][tt] = voff_b(8u * tt + 4u * hi + tq, 4u * (2 * vq + cc) + 2u * tblk + (tp >> 1)) + 8u * (tp & 1u);
            vnat[cc][tt] = voff_b(8u * hi + 4u * tt + tq, 4u * (2 * vq + cc) + 2u * tblk + (tp >> 1)) + 8u * (tp & 1u);
        }
    }
    f32x16 sacc[2];
#pragma unroll
    for (int cc = 0; cc < 2; ++cc)
#pragma unroll
        for (int r = 0; r < 16; ++r) sacc[cc][r] = 0.f;
    { unsigned z = 0u; asm volatile("" : "+v"(z)); for (int i = tid; i < 32768 / 16; i += 512) *(MIX_LAS u32x4*)(lds + SIMG + i * 16) = (u32x4){z, z, z, z}; }
    bf16x8 qf[8];
    RF_LOAD(0); RF_LOADQ(0);
    { float lg2c = lg2; int tidc = tid; asm volatile("" : "+v"(lg2c), "+v"(tidc)); RF_STORE(); }
    RF_BAR();
    for (int c = 0; c < 16; ++c) {
        float lg2c = lg2; int hic = hi, r32c = r32, cs = c, tidc = tid; asm volatile("" : "+v"(lg2c), "+v"(hic), "+v"(r32c), "+s"(cs), "+v"(tidc));
        float lg2c_ = lg2c; (void)lg2c_;
        if (c + 1 < 16 && !(ABL & 16)) { RF_LOAD(c + 1); }
        f32x16 o[2];
#pragma unroll
        for (int cc = 0; cc < 2; ++cc)
#pragma unroll
            for (int r = 0; r < 16; ++r) o[cc][r] = 0.f;
        if (c > 0 && !(ABL & 1)) {
#pragma unroll
            for (int t = 0; t < 2; ++t)
#pragma unroll
                for (int cc = 0; cc < 2; ++cc) {
                    s16x4 lo[4], hh[4];
#pragma unroll
                    for (int ks = 0; ks < 4; ++ks) { lo[ks] = __builtin_amdgcn_ds_read_tr16_b64_v4i16((MIX_LAS s16x4*)(lds + SIMG + t * 16384 + vnat[cc][0] + 4096 * ks));
                                                     hh[ks] = __builtin_amdgcn_ds_read_tr16_b64_v4i16((MIX_LAS s16x4*)(lds + SIMG + t * 16384 + vnat[cc][1] + 4096 * ks)); }
#pragma unroll
                    for (int ks = 0; ks < 4; ++ks) { const bf16x8 vf = (bf16x8){lo[ks][0], lo[ks][1], lo[ks][2], lo[ks][3], hh[ks][0], hh[ks][1], hh[ks][2], hh[ks][3]};
                                                     o[cc] = __builtin_amdgcn_mfma_f32_32x32x16_bf16(qf[4 * t + ks], vf, o[cc], 0, 0, 0); }
                    __builtin_amdgcn_sched_barrier(0);
                }
        }
        const int qloc = 32 * rg + r32c;
#pragma unroll
        for (int kh = 0; kh < 2; ++kh) if (64 * kh <= 32 * rg + 31 && !(ABL & 2)) {
            f32x16 p0, p1;
#pragma unroll
            for (int r = 0; r < 16; ++r) { p0[r] = 0.f; p1[r] = 0.f; }
            const MIX_LAS unsigned char* ki = lds + KIMG + kh * 16384; const unsigned ka = 256u * (unsigned)r32c + 16u * ((unsigned)hic ^ ((((unsigned)r32c & 3u) << 2) | (((unsigned)r32c >> 2) & 3u)));
#pragma unroll
            for (int d0 = 0; d0 < 8; ++d0) {
                const bf16x8 a0 = *(const MIX_LAS bf16x8*)(ki + (ka ^ (32u * d0)));
                const bf16x8 a1 = *(const MIX_LAS bf16x8*)(ki + 8192 + (ka ^ (32u * d0)));
                p0 = __builtin_amdgcn_mfma_f32_32x32x16_bf16(a0, qf[d0], p0, 0, 0, 0);
                p1 = __builtin_amdgcn_mfma_f32_32x32x16_bf16(a1, qf[d0], p1, 0, 0, 0);
                if (d0 & 1) __builtin_amdgcn_sched_barrier(0);
            }
            const int kbase = 64 * kh + 4 * hic;
            if (64 * kh + 63 > 32 * rg) {
#pragma unroll
                for (int r = 0; r < 16; ++r) { const int kp = kbase + (r & 3) + 8 * (r >> 2); if (kp > qloc) p0[r] = 0.f; if (kp + 32 > qloc) p1[r] = 0.f; }
            }
            u32x4 pw[4];
#pragma unroll
            for (int j = 0; j < 4; ++j) { pw[0][j] = pk_bf16(p0[2 * j], p0[2 * j + 1]); pw[1][j] = pk_bf16(p0[8 + 2 * j], p0[9 + 2 * j]);
                                          pw[2][j] = pk_bf16(p1[2 * j], p1[2 * j + 1]); pw[3][j] = pk_bf16(p1[8 + 2 * j], p1[9 + 2 * j]); }
#pragma unroll
            for (int cc = 0; cc < 2; ++cc) {
                s16x4 lo[4], hh[4];
#pragma unroll
                for (int ks = 0; ks < 4; ++ks) { lo[ks] = __builtin_amdgcn_ds_read_tr16_b64_v4i16((MIX_LAS s16x4*)(lds + VIMG + kh * 16384 + vperm[cc][0] + 4096 * ks));
                                                 hh[ks] = __builtin_amdgcn_ds_read_tr16_b64_v4i16((MIX_LAS s16x4*)(lds + VIMG + kh * 16384 + vperm[cc][1] + 4096 * ks)); }
#pragma unroll
                for (int ks = 0; ks < 4; ++ks) { const bf16x8 vf = (bf16x8){lo[ks][0], lo[ks][1], lo[ks][2], lo[ks][3], hh[ks][0], hh[ks][1], hh[ks][2], hh[ks][3]};
                                                 o[cc] = __builtin_amdgcn_mfma_f32_32x32x16_bf16(__builtin_bit_cast(bf16x8, pw[ks]), vf, o[cc], 0, 0, 0); }
                __builtin_amdgcn_sched_barrier(0);
            }
        }
        if (c + 1 < 16 && !(ABL & 16)) { RF_LOADQ(c + 1); }
        { const size_t tok0 = (size_t)b * SEQ + (size_t)cs * 128 + 32 * rg;
          char* ob0 = (char*)(raw + ((size_t)(2 * h + vh) * MT_ROWS + tok0) * 128 + 64 * vq);
          float qa[4]; qa[0] = __builtin_amdgcn_exp2f(lg2c * (float)(32 * rg + 4 * hic - 127));
#pragma unroll
          for (int q = 1; q < 4; ++q) qa[q] = qa[q - 1] * __uint_as_float(gs8);
          if (ABL & 8) {
#pragma unroll
              for (int r = 0; r < 16; ++r) asm volatile("" :: "v"(o[0][r]), "v"(o[1][r]));
          }
          if (!(ABL & 8)) {
              MIX_LAS unsigned char* stg = lds + OIMG + wave * 4096;
              const unsigned wb = 512u * (unsigned)hic + 2u * (unsigned)r32c;
#pragma unroll
              for (int r = 0; r < 16; ++r) {
                  const unsigned cr = (r & 3) + 8 * (r >> 2);
                  const float fo = qa[r >> 2] * __uint_as_float(gs[r & 3]);
                  const unsigned pk = pk_bf16(o[0][r] * fo, o[1][r] * fo);
                  *(MIX_LAS bf16_t*)(stg + wb + cr * 128u) = (bf16_t)(pk & 0xffffu); *(MIX_LAS bf16_t*)(stg + wb + cr * 128u + 64u) = (bf16_t)(pk >> 16);
              }
              const unsigned lanec = (unsigned)r32c + 32u * (unsigned)hic;
              const unsigned ro = (lanec >> 3) * 128u + (lanec & 7u) * 16u;
              char* og = ob0 + (lanec >> 3) * 256u + (lanec & 7u) * 16u;
#pragma unroll
              for (int i = 0; i < 4; ++i) { const u32x4 w = *(const MIX_LAS u32x4*)(stg + ro + i * 1024); *(u32x4*)(og + i * 2048) = w; }
          } }
        if (!(ABL & 4))
#pragma unroll
        for (int ks8 = 0; ks8 < 8; ++ks8) {
            const MIX_LAS unsigned char* ki = lds + KIMG + (ks8 >> 2) * 16384 + (ks8 & 3) * 4096; const MIX_LAS unsigned char* vi = lds + VIMG + (ks8 >> 2) * 16384 + (ks8 & 3) * 4096;
            const s16x4 a0 = __builtin_amdgcn_ds_read_tr16_b64_v4i16((MIX_LAS s16x4*)(ki + knat[0])), a1 = __builtin_amdgcn_ds_read_tr16_b64_v4i16((MIX_LAS s16x4*)(ki + knat[1]));
            const bf16x8 af = (bf16x8){a0[0], a0[1], a0[2], a0[3], a1[0], a1[1], a1[2], a1[3]};
#pragma unroll
            for (int cc = 0; cc < 2; ++cc) {
                const s16x4 b0 = __builtin_amdgcn_ds_read_tr16_b64_v4i16((MIX_LAS s16x4*)(vi + vnat[cc][0])), b1 = __builtin_amdgcn_ds_read_tr16_b64_v4i16((MIX_LAS s16x4*)(vi + vnat[cc][1]));
                const bf16x8 bfr = (bf16x8){b0[0], b0[1], b0[2], b0[3], b1[0], b1[1], b1[2], b1[3]};
                sacc[cc] = __builtin_amdgcn_mfma_f32_32x32x16_bf16(af, bfr, sacc[cc], 0, 0, 0);
            }
            if (ks8 & 1) __builtin_amdgcn_sched_barrier(0);
        }
#pragma unroll
        for (int cc = 0; cc < 2; ++cc)
#pragma unroll
            for (int r = 0; r < 16; ++r) sacc[cc][r] *= g128;
        RF_BAR();
        if (c + 1 < 16) {
            RF_STORE();
            if (!(ABL & 32)) {
            const unsigned sa = (unsigned)(SIMG + (rg >> 1) * 16384 + (rg & 1) * 8192) + 1024u * (unsigned)hic + 16u * ((8u * vq + ((unsigned)r32c >> 3)) ^ (unsigned)hic) + 2u * ((unsigned)r32c & 7u);
#pragma unroll
            for (int cc = 0; cc < 2; ++cc)
#pragma unroll
                for (int r = 0; r < 16; r += 2) {
                    const unsigned pk = pk_bf16(sacc[cc][r], sacc[cc][r + 1]);
                    const unsigned c0 = 16u * ((4u * cc) ^ ((((unsigned)r & 3u) << 2) | (2u * (((unsigned)r >> 2) & 1u)))), c1 = 16u * ((4u * cc) ^ ((((unsigned)(r + 1) & 3u) << 2) | (2u * (((unsigned)(r + 1) >> 2) & 1u))));
                    *(MIX_LAS bf16_t*)(lds + ((sa ^ c0) + 256u * ((r & 3) + 8 * (r >> 2)))) = (bf16_t)(pk & 0xffffu);
                    *(MIX_LAS bf16_t*)(lds + ((sa ^ c1) + 256u * (((r + 1) & 3) + 8 * ((r + 1) >> 2)))) = (bf16_t)(pk >> 16);
                }
            }
        }
        RF_BAR();
    }
    __syncthreads();
#undef RF_LOAD
#undef RF_STORE
#undef RF_LOADQ
#undef RF_BAR
}
__device__ __forceinline__ void ret_norm_row(const MixArgs& A, const bf16_t* raw, const float* stats, size_t tok, int lane) {
    const bf16_t* gr = A.P + tok * LDPS + S_RG; unsigned char* orow = A.reto + tok * 4096;
#pragma unroll
    for (int j = 0; j < 8; ++j) {
        const int col = j * 512 + lane * 8;
        const u32x4 xr = *(const u32x4*)(raw + ((size_t)(col >> 7) * 16384 + tok) * 128 + (col & 127)), gq = *(const u32x4*)(gr + col);
        const f32x4v w0 = *(const f32x4v*)(A.gn_w + col), w1 = *(const f32x4v*)(A.gn_w + col + 4), b0 = *(const f32x4v*)(A.gn_b + col), b1 = *(const f32x4v*)(A.gn_b + col + 4);
        float x[8] = {__uint_as_float(xr.x << 16), __uint_as_float(xr.x & 0xffff0000u), __uint_as_float(xr.y << 16), __uint_as_float(xr.y & 0xffff0000u),
                      __uint_as_float(xr.z << 16), __uint_as_float(xr.z & 0xffff0000u), __uint_as_float(xr.w << 16), __uint_as_float(xr.w & 0xffff0000u)};
        float g[8] = {__uint_as_float(gq.x << 16), __uint_as_float(gq.x & 0xffff0000u), __uint_as_float(gq.y << 16), __uint_as_float(gq.y & 0xffff0000u),
                      __uint_as_float(gq.z << 16), __uint_as_float(gq.z & 0xffff0000u), __uint_as_float(gq.w << 16), __uint_as_float(gq.w & 0xffff0000u)};
        float s1 = 0.f, s2 = 0.f;
#pragma unroll
        for (int i = 0; i < 8; ++i) { s1 += x[i]; s2 += x[i] * x[i]; }
        s1 = sum32(s1); s2 = sum32(s2);
        const float mu = s1 * (1.0f / 256.0f), var = fmaxf(s2 * (1.0f / 256.0f) - mu * mu, 0.f), rs = rsqrtf(var + LN_EPS);
        float y[8];
#pragma unroll
        for (int i = 0; i < 4; ++i) { y[i] = (x[i] - mu) * rs * w0[i] + b0[i]; y[4 + i] = (x[4 + i] - mu) * rs * w1[i] + b1[i]; }
#pragma unroll
        for (int i = 0; i < 8; ++i) y[i] *= RET_SCALE * g[i] * __builtin_amdgcn_rcpf(1.0f + __builtin_amdgcn_exp2f(-g[i] * LOG2E));
        pg8::u32x2 w; w.x = pg8::pk4_fp8(y[0], y[1], y[2], y[3]); w.y = pg8::pk4_fp8(y[4], y[5], y[6], y[7]);
        *(pg8::u32x2*)(orow + col) = w;
    }
}
}

namespace peer {
typedef unsigned short bf16_t;
typedef short bf16x8 __attribute__((ext_vector_type(8)));
typedef float f32x16 __attribute__((ext_vector_type(16)));
typedef __bf16 bf16x2 __attribute__((ext_vector_type(2)));
__device__ __forceinline__ unsigned umax_(unsigned a, unsigned b) { return a > b ? a : b; }
__device__ __forceinline__ unsigned umin_(unsigned a, unsigned b) { return a < b ? a : b; }
__device__ __forceinline__ void sort16(unsigned (&a)[16]) {
#pragma unroll
    for (int k = 2; k <= 16; k <<= 1)
#pragma unroll
        for (int j = k >> 1; j > 0; j >>= 1)
#pragma unroll
            for (int i = 0; i < 16; ++i) { const int l = i ^ j; if (l > i) { const unsigned hi = umax_(a[i], a[l]), lo = umin_(a[i], a[l]); if ((i & k) == 0) { a[i] = hi; a[l] = lo; } else { a[i] = lo; a[l] = hi; } } }
}
__device__ __forceinline__ void merge16(unsigned (&a)[16], const unsigned (&b)[16]) {
#pragma unroll
    for (int i = 0; i < 16; ++i) a[i] = umax_(a[i], b[15 - i]);
#pragma unroll
    for (int s = 8; s > 0; s >>= 1)
#pragma unroll
        for (int i = 0; i < 16; ++i) if ((i & s) == 0) { const unsigned hi = umax_(a[i], a[i + s]), lo = umin_(a[i], a[i + s]); a[i] = hi; a[i + s] = lo; }
}
__device__ __forceinline__ void score_block(unsigned (&S)[16], const bf16_t* kp, const bf16x8 (&qf)[8], int keybase) {
    f32x16 acc;
#pragma unroll
    for (int r = 0; r < 16; ++r) acc[r] = 0.f;
#pragma unroll
    for (int ks = 0; ks < 8; ++ks) { const bf16x8 a = *(const bf16x8*)(kp + ks * 16); acc = __builtin_amdgcn_mfma_f32_32x32x16_bf16(a, qf[ks], acc, 0, 0, 0); }
#pragma unroll
    for (int r = 0; r < 16; ++r) {
        const int key = keybase + (r & 3) + 8 * (r >> 2);
        const float f = fminf(fmaxf((acc[r] + 16.0f) * 1048576.0f, 0.f), 33554431.0f);
        S[r] = ((unsigned)f << 7) | (unsigned)(127 - key);
    }
    sort16(S);
}
__device__ __forceinline__ void subkey_top16(unsigned (&Lo)[16], const bf16_t* QPt, const bf16_t* KEYS, int h, int c, int r32, int hi) {
    bf16x8 qf[8];
#pragma unroll
    for (int ks = 0; ks < 8; ++ks) qf[ks] = *(const bf16x8*)(QPt + h * 256 + c * 128 + ks * 16 + hi * 8);
    const bf16_t* kp = KEYS + ((size_t)((h * 2 + c) * 128 + r32)) * 128 + hi * 8;
    unsigned S1[16], S2[16];
    score_block(Lo, kp, qf, 4 * hi);
    score_block(S1, kp + 32 * 128, qf, 32 + 4 * hi);
    merge16(Lo, S1);
    score_block(S1, kp + 64 * 128, qf, 64 + 4 * hi);
    score_block(S2, kp + 96 * 128, qf, 96 + 4 * hi);
    merge16(S1, S2); merge16(Lo, S1);
    const unsigned pm = 0u - (unsigned)hi;
#pragma unroll
    for (int i = 0; i < 16; ++i) { auto rr = __builtin_amdgcn_permlane32_swap(Lo[i], Lo[i], false, false); S1[i] = (rr[0] & pm) | (rr[1] & ~pm); }
    merge16(Lo, S1);
}
#define PEER_LAS __attribute__((address_space(3)))
constexpr int ENT_PITCH = 132;
__device__ __forceinline__ void topk_item(const bf16_t* QP, const bf16_t* KEYS, PEER_LAS unsigned* ent, int g, int h) {
    const int lane = threadIdx.x & 63, r32 = lane & 31, hi = lane >> 5;
    const size_t tok = (size_t)g * 32 + r32;
    unsigned L0[16], L1[16];
    subkey_top16(L0, QP + tok * 2048, KEYS, h, 0, r32, hi);
    subkey_top16(L1, QP + tok * 2048, KEYS, h, 1, r32, hi);
    unsigned C0[16], C1[16], C2[16], C3[16];
#define CAND(a, b) ((((((L0[a] >> 7) + (L1[b] >> 7)) >> 8) << 14)) | ((127u - (L0[a] & 127u)) << 7) | (127u - (L1[b] & 127u)))
#pragma unroll
    for (int b = 0; b < 16; ++b) C0[b] = CAND(0, b);
#pragma unroll
    for (int b = 0; b < 8; ++b) C1[b] = CAND(1, b);
#pragma unroll
    for (int b = 0; b < 5; ++b) C1[8 + b] = CAND(2, b);
    C1[13] = CAND(3, 0); C1[14] = CAND(3, 1); C1[15] = CAND(3, 2);
    C2[0] = CAND(3, 3); C2[1] = CAND(4, 0); C2[2] = CAND(4, 1); C2[3] = CAND(4, 2); C2[4] = CAND(5, 0); C2[5] = CAND(5, 1); C2[6] = CAND(6, 0); C2[7] = CAND(6, 1);
    C2[8] = CAND(7, 0); C2[9] = CAND(7, 1); C2[10] = CAND(8, 0); C2[11] = CAND(9, 0); C2[12] = CAND(10, 0); C2[13] = CAND(11, 0); C2[14] = CAND(12, 0); C2[15] = CAND(13, 0);
    C3[0] = CAND(14, 0); C3[1] = CAND(15, 0);
#pragma unroll
    for (int b = 2; b < 16; ++b) C3[b] = 0u;
#undef CAND
    sort16(C0); sort16(C1); sort16(C2); sort16(C3);
    merge16(C0, C1); merge16(C2, C3); merge16(C0, C2);
    float sc[16], sum;
    const float mx = (float)(C0[0] >> 14) * (1.0f / 4096.0f); sum = 0.f;
#pragma unroll
    for (int k = 0; k < 16; ++k) { sc[k] = __expf((float)(C0[k] >> 14) * (1.0f / 4096.0f) - mx); sum += sc[k]; }
    const float inv = 1.0f / sum;
    const unsigned hmask = 0u - (unsigned)hi;
#pragma unroll
    for (int k = 0; k < 8; ++k) {
        const unsigned key = (C0[8 + k] & hmask) | (C0[k] & ~hmask); const float gt = __uint_as_float((__float_as_uint(sc[8 + k]) & hmask) | (__float_as_uint(sc[k]) & ~hmask)) * inv;
        ent[r32 * ENT_PITCH + h * 16 + hi * 8 + k] = ((key & 16383u) << 16) | (__float_as_uint(gt) >> 16);
    }
}
__device__ __forceinline__ void topk_store(const PEER_LAS unsigned* ent, unsigned char* G8, int g) {
    const int tid = threadIdx.x, tok = tid >> 4;
    const PEER_LAS unsigned* row = ent + tok * ENT_PITCH;
#pragma unroll 1
    for (int i = 0; i < 8; ++i) {
        const int j = (tid & 15) + 16 * i;
        const unsigned me = row[j], e = me >> 16; float sum = 0.f; bool dup = false;
        for (int q = 0; q < 128; q += 4) {
            const unsigned w0 = row[q], w1 = row[q + 1], w2 = row[q + 2], w3 = row[q + 3];
            if ((w0 >> 16) == e) { sum += __uint_as_float(w0 << 16); dup |= (q < j); }
            if ((w1 >> 16) == e) { sum += __uint_as_float(w1 << 16); dup |= (q + 1 < j); }
            if ((w2 >> 16) == e) { sum += __uint_as_float(w2 << 16); dup |= (q + 2 < j); }
            if ((w3 >> 16) == e) { sum += __uint_as_float(w3 << 16); dup |= (q + 3 < j); }
        }
        if (!dup) G8[((size_t)g * 32 + tok) * NE + e] = (unsigned char)(pg8::pk4_fp8(sum * 64.0f, 0.f, 0.f, 0.f) & 0xffu);
    }
}
typedef unsigned u32x4p __attribute__((ext_vector_type(4)));
__device__ __forceinline__ void topk_store_dense(const PEER_LAS unsigned* ent, PEER_LAS unsigned char* rowbuf, unsigned char* G8, int g) {
    const int tid = threadIdx.x, tl = tid >> 7, j = tid & 127;
    PEER_LAS unsigned* accw = (PEER_LAS unsigned*)(rowbuf - 2048) + tl * 128;
#define PEER_LBAR() asm volatile("s_waitcnt lgkmcnt(0)\n\ts_barrier" ::: "memory")
#pragma unroll 1
    for (int rd = 0; rd < 8; ++rd) {
        { unsigned zz = 0u; asm volatile("" : "+v"(zz)); const u32x4p z = {zz, zz, zz, zz};
#pragma unroll
          for (int i = 0; i < 8; ++i) *(PEER_LAS u32x4p*)(rowbuf + (tid + 512 * i) * 16) = z; }
        const unsigned me = ent[(rd * 4 + tl) * ENT_PITCH + j], e = me >> 16;
        const unsigned gfix = (unsigned)(__uint_as_float(me << 16) * 16777216.0f);
        PEER_LAS unsigned char* cell = rowbuf + tl * 16384 + e;
        PEER_LBAR();
        *cell = (unsigned char)(j + 1); accw[j] = gfix;
        PEER_LBAR();
        const int own = (int)*cell - 1;
        if (own != j) __hip_atomic_fetch_add(accw + own, gfix, __ATOMIC_RELAXED, __HIP_MEMORY_SCOPE_WORKGROUP);
        PEER_LBAR();
        if (own == j) *cell = (unsigned char)(pg8::pk4_fp8((float)accw[j] * (64.0f / 16777216.0f), 0.f, 0.f, 0.f) & 0xffu);
        PEER_LBAR();
        { unsigned char* dst = G8 + ((size_t)g * 32 + rd * 4) * NE;
#pragma unroll
          for (int i = 0; i < 8; ++i) { const u32x4p w = *(const PEER_LAS u32x4p*)(rowbuf + (tid + 512 * i) * 16); *(u32x4p*)(dst + (size_t)(tid + 512 * i) * 16) = w; } }
        PEER_LBAR();
    }
#undef PEER_LBAR
}
}

constexpr int NWAVES = 8;
#ifndef MK_N_LAUNCHES
#define MK_N_LAUNCHES 1
#endif
constexpr int N_PHASES = 11;
constexpr int N_LAUNCHES = MK_N_LAUNCHES;
static_assert(N_LAUNCHES == 1 || N_LAUNCHES == N_PHASES, "MK_N_LAUNCHES is 1 or 11");

constexpr size_t MiB = 1u << 20;
constexpr size_t WS_CTL = 0, CTL_ZERO_BYTES = 64 * 1024;
constexpr size_t WS_KEYS = 1 * MiB;
constexpr size_t WS_WDA = 2 * MiB, WS_WRET = 18 * MiB, WS_WOUT = 50 * MiB, WS_WQ = 82 * MiB, WS_UB = 98 * MiB, WS_VT = 226 * MiB;
constexpr size_t WS_XB = 354 * MiB, WS_WIN = 482 * MiB, WS_PROJ = 690 * MiB, WS_X1F8 = 1522 * MiB, WS_END = 1586 * MiB;
constexpr size_t WS_A8 = 354 * MiB;
#ifndef FP6_P1
#define FP6_P1 1
#endif
#ifndef FP6_P8
#define FP6_P8 1
#endif
constexpr float X_SCALE = 2.0f, X1_SCALE = 2.0f, WIN6_SCALE = 128.0f, U6_SCALE = 128.0f, WQ6_SCALE = 128.0f;
constexpr float WIN_SCALE = 64.0f, WDA_SCALE = 64.0f, WRET_SCALE = 128.0f, WOUT_SCALE = 128.0f, M_SCALE = 16.0f;
constexpr float U_SCALE = 64.0f, V_SCALE = 8.0f, A_SCALE = 64.0f;
#ifndef PROBE_ABL
#define PROBE_ABL 0
#endif
#ifndef RET_FUSED
#define RET_FUSED 1
#endif
constexpr size_t WS_RQKV = 1266 * MiB;
constexpr size_t WS_RSTATS = 642 * MiB;
constexpr size_t WS_STATE = 450 * MiB;
constexpr size_t WS_ATTO = 354 * MiB, WS_RETO = 386 * MiB, WS_MERGED = 450 * MiB, WS_MERGED8 = 578 * MiB;
constexpr size_t WS_Z1 = 1266 * MiB, WS_X1B = 818 * MiB, WS_QP = 946 * MiB, WS_G = 1010 * MiB;
static_assert(WS_A8 + (size_t)MT * NE <= WS_PROJ && WS_MERGED + (size_t)MT * DM * 2 <= WS_MERGED8 && WS_MERGED8 + (size_t)MT * DM <= WS_PROJ && WS_G + (size_t)MT * NE * 2 <= WS_X1F8 && WS_WIN + (size_t)LDP * DM * 2 <= WS_PROJ && WS_PROJ + (size_t)MT * LDP * 2 <= WS_X1F8, "d_ws map");
constexpr int CW_BAR = 1024;

constexpr int RING_BYTES = 131072, LDSCTL_OFF = RING_BYTES, MISC_OFF = LDSCTL_OFF + 320, LDS_BYTES = 147456;

#define GAS __attribute__((address_space(1)))
#define LAS __attribute__((address_space(3)))
typedef unsigned short bf16;
typedef unsigned v4u __attribute__((ext_vector_type(4)));
typedef float f32x4 __attribute__((ext_vector_type(4)));
#define LDS_WAIT() asm volatile("s_waitcnt lgkmcnt(0)" ::: "memory")
__device__ __forceinline__ unsigned f2bf(float f) { unsigned u = __builtin_bit_cast(unsigned, f); return (u + 0x7fffu + ((u >> 16) & 1u)) >> 16; }
__device__ __forceinline__ unsigned pk2(float lo, float hi) { return f2bf(lo) | (f2bf(hi) << 16); }

#define XB_TMO      128
#define XB_XCNT(j)  (256  + 64 * (j))
#define XB_XSUB(j)  (1280 + 64 * (j))
#define XB_XGEN(j)  (2304 + 64 * (j))
#define XB_TOP      3328
#define XB_TOPGEN   3392
#define XCD_BAR_WORDS 3456
#define XB_SPIN_CAP (1u << 18)

__device__ __forceinline__ unsigned xb_ld(unsigned* p)              { return __hip_atomic_load(p, __ATOMIC_RELAXED, __HIP_MEMORY_SCOPE_AGENT); }
__device__ __forceinline__ unsigned xb_add(unsigned* p, unsigned v) { return __hip_atomic_fetch_add(p, v, __ATOMIC_RELAXED, __HIP_MEMORY_SCOPE_AGENT); }
__device__ __forceinline__ unsigned xb_xcc_id() { return (unsigned)__builtin_amdgcn_s_getreg((3 << 11) | 20) & 0xFu; }
#define XB_SPIN(cond, bar) do { unsigned _sp = 0; while (cond) { __builtin_amdgcn_s_sleep(1); \
    if ((++_sp & 255u) == 0u) { if (xb_ld(&(bar)[XB_TMO])) break; if (_sp > XB_SPIN_CAP) { atomicAdd(&(bar)[XB_TMO], 1u); break; } } } } while (0)

struct XcdBarrier {
    unsigned* bar; unsigned x;
    volatile LAS unsigned* st;
};

__device__ __forceinline__ XcdBarrier xcd_barrier_post(unsigned* bar, volatile LAS unsigned* st) {
    XcdBarrier b; b.bar = bar; b.x = xb_xcc_id(); b.st = st;
    if (threadIdx.x == 0) (void)xb_add(&bar[XB_XCNT(b.x)], 1u);
    return b;
}
__device__ __forceinline__ void xcd_barrier_complete(unsigned* bar, unsigned x, unsigned& nloc, unsigned& nx) {
    const unsigned G = gridDim.x * gridDim.y * gridDim.z;
    unsigned sum, cnt, mine, sp = 0u;
    for (;;) {
        sum = 0u; cnt = 0u; mine = 0u;
#pragma unroll
        for (unsigned j = 0; j < 16; ++j) { const unsigned c = xb_ld(&bar[XB_XCNT(j)]); sum += c; cnt += (c > 0u) ? 1u : 0u; mine = (j == x) ? c : mine; }
        if (sum == G) break;
        __builtin_amdgcn_s_sleep(1);
        if ((++sp & 255u) == 0u) { if (xb_ld(&bar[XB_TMO])) break; if (sp > XB_SPIN_CAP) { atomicAdd(&bar[XB_TMO], 1u); break; } }
    }
    nloc = mine > 0u ? mine : 1u; nx = cnt > 0u ? cnt : 1u;
}

__device__ __forceinline__ void xcd_barrier(const XcdBarrier& b) {
    asm volatile("s_waitcnt vmcnt(0)" ::: "memory");
    __syncthreads();
    if (threadIdx.x == 0) {
        unsigned* bar = b.bar;
        __builtin_amdgcn_s_waitcnt(0);
        unsigned nloc = b.st[0], nx = b.st[1];
        if (nloc == 0u) { xcd_barrier_complete(bar, b.x, nloc, nx); b.st[0] = nloc; b.st[1] = nx; }
        const unsigned old = xb_add(&bar[XB_XSUB(b.x)], 1u);
        const unsigned gen = old / nloc;
        if (old + 1u == (gen + 1u) * nloc) {
            __builtin_amdgcn_fence(__ATOMIC_RELEASE, "agent");
            asm volatile("s_waitcnt vmcnt(0)" ::: "memory");
            const unsigned og = xb_add(&bar[XB_TOP], 1u);
            const unsigned tg = og / nx;
            if (og + 1u == (tg + 1u) * nx) xb_add(&bar[XB_TOPGEN], 1u);
            else XB_SPIN(xb_ld(&bar[XB_TOPGEN]) == tg, bar);
            __builtin_amdgcn_fence(__ATOMIC_ACQUIRE, "agent");
            xb_add(&bar[XB_XGEN(b.x)], 1u);
            asm volatile("s_waitcnt vmcnt(0)" ::: "memory");
        } else {
            XB_SPIN(xb_ld(&bar[XB_XGEN(b.x)]) == gen, bar);
            __builtin_amdgcn_fence(__ATOMIC_ACQUIRE, "agent");
            asm volatile("s_waitcnt vmcnt(0)" ::: "memory");
        }
    }
    __syncthreads();
}


struct Frame {
    LAS unsigned char* lds; volatile LAS unsigned* MISC; unsigned* ctl;
    int tid, lane, wave, vcu, G;
};
__device__ __forceinline__ float wave_sum(float v) {
#pragma unroll
    for (int o = 1; o < 64; o <<= 1) v += __shfl_xor(v, o);
    return v;
}
__device__ __forceinline__ void p0_transpose_item(const float* W, int K, int N, bf16* WT, LAS float* scr, int item, int lane, float scale) {
    const int nblk = N / 32, kb = item / nblk, nb = item % nblk, k0 = 64 * kb, n0 = 32 * nb;
#pragma unroll 8
    for (int i = 0; i < 32; ++i) { const int kk = 2 * i + (lane >> 5); scr[kk * 33 + (lane & 31)] = W[(size_t)(k0 + kk) * N + n0 + (lane & 31)] * scale; }
    LDS_WAIT(); asm volatile("" ::: "memory");
    const int c = lane & 7;
#pragma unroll
    for (int j = 0; j < 4; ++j) { const int n = (lane >> 3) + 8 * j; const LAS float* s = scr + (8 * c) * 33 + n;
        v4u o; o.x = pk2(s[0 * 33], s[1 * 33]); o.y = pk2(s[2 * 33], s[3 * 33]); o.z = pk2(s[4 * 33], s[5 * 33]); o.w = pk2(s[6 * 33], s[7 * 33]);
        *(GAS v4u*)(WT + (size_t)(n0 + n) * K + k0 + 8 * c) = o; }
    LDS_WAIT(); asm volatile("" ::: "memory");
}
__device__ __forceinline__ void p0_transpose_item_f8(const float* W, int K, int N, unsigned char* WT, LAS float* scr, int item, int lane, float scale) {
    const int nblk = N / 32, kb = item / nblk, nb = item % nblk, k0 = 64 * kb, n0 = 32 * nb;
#pragma unroll 8
    for (int i = 0; i < 32; ++i) { const int kk = 2 * i + (lane >> 5); scr[kk * 33 + (lane & 31)] = W[(size_t)(k0 + kk) * N + n0 + (lane & 31)] * scale; }
    LDS_WAIT(); asm volatile("" ::: "memory");
    const int c = lane & 7;
#pragma unroll
    for (int j = 0; j < 4; ++j) { const int n = (lane >> 3) + 8 * j; const LAS float* s = scr + (8 * c) * 33 + n;
        pg8::u32x2 o; o.x = pg8::pk4_fp8(s[0 * 33], s[1 * 33], s[2 * 33], s[3 * 33]); o.y = pg8::pk4_fp8(s[4 * 33], s[5 * 33], s[6 * 33], s[7 * 33]);
        *(GAS pg8::u32x2*)(WT + (size_t)(n0 + n) * K + k0 + 8 * c) = o; }
    LDS_WAIT(); asm volatile("" ::: "memory");
}
__device__ __forceinline__ void p0_transpose_item_f6(const float* W, int K, int N, unsigned char* WT, LAS float* scr, int item, int lane, float scale) {
    const int nblk = N / 32, kb = item / nblk, nb = item % nblk, k0 = 64 * kb, n0 = 32 * nb;
#pragma unroll 8
    for (int i = 0; i < 32; ++i) { const int kk = 2 * i + (lane >> 5); scr[kk * 33 + (lane & 31)] = W[(size_t)(k0 + kk) * N + n0 + (lane & 31)] * scale; }
    LDS_WAIT(); asm volatile("" ::: "memory");
    const int n = lane & 31, hf = lane >> 5; float x[32];
#pragma unroll
    for (int i = 0; i < 32; ++i) x[i] = scr[(32 * hf + i) * 33 + n];
    pg8::u32x4 lo, hi; pg8::cvt_block_fp6(x, lo, hi);
    GAS pg8::u32x4* o = (GAS pg8::u32x4*)(WT + (size_t)(n0 + n) * K + k0 + 32 * hf); o[0] = lo; o[1] = hi;
    LDS_WAIT(); asm volatile("" ::: "memory");
}
__device__ __forceinline__ void cvt_flat_f6(const float* src, unsigned char* dst, size_t n32, size_t gt, size_t gs, float scale) {
    for (size_t i = gt; i < n32; i += gs) { float x[32];
#pragma unroll
        for (int j = 0; j < 8; ++j) { const f32x4 v = *(const f32x4*)(src + i * 32 + 4 * j) * scale; x[4 * j] = v[0]; x[4 * j + 1] = v[1]; x[4 * j + 2] = v[2]; x[4 * j + 3] = v[3]; }
        pg8::u32x4 lo, hi; pg8::cvt_block_fp6(x, lo, hi); pg8::u32x4* o = (pg8::u32x4*)(dst + i * 32); o[0] = lo; o[1] = hi; }
}
__device__ __forceinline__ void cvt_flat_f6_lds(const float* src, unsigned char* dst, int nwb, int gw, int ngw, int lane, LAS unsigned char* scr, float scale) {
    for (int wb = gw; wb < nwb; wb += ngw) {
        const float* s = src + (size_t)wb * 2048;
#pragma unroll
        for (int j = 0; j < 8; ++j) { const int piece = j * 64 + lane; const f32x4 v = *(const f32x4*)(s + piece * 4) * scale; *(LAS f32x4*)(scr + (piece >> 3) * 144 + (piece & 7) * 16) = v; }
        LDS_WAIT(); asm volatile("" ::: "memory");
        float x[32];
#pragma unroll
        for (int p = 0; p < 8; ++p) { const f32x4 t = *(const LAS f32x4*)(scr + lane * 144 + p * 16); x[4 * p] = t[0]; x[4 * p + 1] = t[1]; x[4 * p + 2] = t[2]; x[4 * p + 3] = t[3]; }
        pg8::u32x4 lo, hi; pg8::cvt_block_fp6(x, lo, hi); pg8::u32x4* o = (pg8::u32x4*)(dst + ((size_t)wb * 64 + lane) * 32); o[0] = lo; o[1] = hi;
        LDS_WAIT(); asm volatile("" ::: "memory");
    }
}
__device__ __forceinline__ void cvt_flat_f8(const float* src, unsigned char* dst, size_t n16, size_t gt, size_t gs, float scale) {
    for (size_t i = gt; i < n16; i += gs) { const f32x4 a = *(const f32x4*)(src + i * 16) * scale, b = *(const f32x4*)(src + i * 16 + 4) * scale, c = *(const f32x4*)(src + i * 16 + 8) * scale, e = *(const f32x4*)(src + i * 16 + 12) * scale;
        v4u o; o.x = pg8::pk4_fp8(a[0], a[1], a[2], a[3]); o.y = pg8::pk4_fp8(b[0], b[1], b[2], b[3]); o.z = pg8::pk4_fp8(c[0], c[1], c[2], c[3]); o.w = pg8::pk4_fp8(e[0], e[1], e[2], e[3]); *(v4u*)(dst + i * 16) = o; }
}
__device__ __forceinline__ void cvt_flat(const float* src, bf16* dst, size_t n8, size_t gt, size_t gs) {
    for (size_t i = gt; i < n8; i += gs) { const f32x4 a = *(const f32x4*)(src + i * 8), b = *(const f32x4*)(src + i * 8 + 4);
        v4u o; o.x = pk2(a[0], a[1]); o.y = pk2(a[2], a[3]); o.z = pk2(b[0], b[1]); o.w = pk2(b[2], b[3]); *(v4u*)(dst + i * 8) = o; }
}
template <bool OUTF32> __device__ __forceinline__ void ln_row(const bf16* zrow, const float* w, const float* b, void* orow, unsigned char* o8row, int lane, LAS unsigned char* scr) {
    float x[64]; float s = 0.f;
#pragma unroll
    for (int j = 0; j < 8; ++j) { const v4u v = *(const v4u*)(zrow + j * 512 + lane * 8);
        x[8 * j + 0] = __uint_as_float(v.x << 16); x[8 * j + 1] = __uint_as_float(v.x & 0xffff0000u); x[8 * j + 2] = __uint_as_float(v.y << 16); x[8 * j + 3] = __uint_as_float(v.y & 0xffff0000u);
        x[8 * j + 4] = __uint_as_float(v.z << 16); x[8 * j + 5] = __uint_as_float(v.z & 0xffff0000u); x[8 * j + 6] = __uint_as_float(v.w << 16); x[8 * j + 7] = __uint_as_float(v.w & 0xffff0000u); }
#pragma unroll
    for (int i = 0; i < 64; ++i) s += x[i];
    const float mean = wave_sum(s) * (1.0f / 4096.0f); float q = 0.f;
#pragma unroll
    for (int i = 0; i < 64; ++i) { x[i] -= mean; q += x[i] * x[i]; }
    const float rstd = rsqrtf(wave_sum(q) * (1.0f / 4096.0f) + LN_EPS);
#pragma unroll
    for (int j = 0; j < 8; ++j) { const int col = j * 512 + lane * 8;
        const f32x4 w0 = *(const f32x4*)(w + col), w1 = *(const f32x4*)(w + col + 4), b0 = *(const f32x4*)(b + col), b1 = *(const f32x4*)(b + col + 4);
        float y[8];
#pragma unroll
        for (int i = 0; i < 4; ++i) { y[i] = x[8 * j + i] * rstd * w0[i] + b0[i]; y[4 + i] = x[8 * j + 4 + i] * rstd * w1[i] + b1[i]; }
        if (OUTF32) { *(f32x4*)((float*)orow + col) = (f32x4){y[0], y[1], y[2], y[3]}; *(f32x4*)((float*)orow + col + 4) = (f32x4){y[4], y[5], y[6], y[7]}; }
        else { v4u o; o.x = pk2(y[0], y[1]); o.y = pk2(y[2], y[3]); o.z = pk2(y[4], y[5]); o.w = pk2(y[6], y[7]); *(v4u*)((bf16*)orow + col) = o;
               if (FP6_P8) *(LAS v4u*)(scr + (j * 16 + (lane >> 2)) * 80 + (lane & 3) * 16) = o;
               else { pg8::u32x2 o8; o8.x = pg8::pk4_fp8(y[0], y[1], y[2], y[3]); o8.y = pg8::pk4_fp8(y[4], y[5], y[6], y[7]); *(pg8::u32x2*)(o8row + col) = o8; } } }
    if (!OUTF32 && FP6_P8) {
        LDS_WAIT(); asm volatile("" ::: "memory");
#pragma unroll
        for (int blk = 0; blk < 2; ++blk) { float xb[32];
#pragma unroll
            for (int j = 0; j < 4; ++j) { const v4u v = *(const LAS v4u*)(scr + (2 * lane + blk) * 80 + j * 16);
                xb[8 * j + 0] = __uint_as_float(v.x << 16) * X1_SCALE; xb[8 * j + 1] = __uint_as_float(v.x & 0xffff0000u) * X1_SCALE; xb[8 * j + 2] = __uint_as_float(v.y << 16) * X1_SCALE; xb[8 * j + 3] = __uint_as_float(v.y & 0xffff0000u) * X1_SCALE;
                xb[8 * j + 4] = __uint_as_float(v.z << 16) * X1_SCALE; xb[8 * j + 5] = __uint_as_float(v.z & 0xffff0000u) * X1_SCALE; xb[8 * j + 6] = __uint_as_float(v.w << 16) * X1_SCALE; xb[8 * j + 7] = __uint_as_float(v.w & 0xffff0000u) * X1_SCALE; }
            pg8::u32x4 lo, hi; pg8::cvt_block_fp6(xb, lo, hi); pg8::u32x4* o = (pg8::u32x4*)(o8row + 64 * lane + 32 * blk); o[0] = lo; o[1] = hi; }
        LDS_WAIT(); asm volatile("" ::: "memory");
    }
}

struct Args { const float* in[17]; float* out; unsigned char* ws; int ph_lo, ph_hi, li, pad; };
__global__ void __launch_bounds__(NWAVES * 64, 2) mk_fwd(Args args) {
    extern __shared__ __attribute__((aligned(16))) unsigned char lds[];
    Frame F;
    F.lds = (LAS unsigned char*)lds; F.MISC = (volatile LAS unsigned*)(F.lds + MISC_OFF);
    F.tid = threadIdx.x; F.lane = F.tid & 63; F.wave = __builtin_amdgcn_readfirstlane(F.tid >> 6);
    F.G = gridDim.x; { const int bx = blockIdx.x; F.vcu = (F.G % 8 == 0) ? (bx % 8) * (F.G / 8) + bx / 8 : bx; }
    unsigned char* ws = args.ws;
    F.ctl = (unsigned*)(ws + WS_CTL);
    for (int u = F.tid; u < (LDS_BYTES - LDSCTL_OFF) / 4; u += NWAVES * 64) ((LAS unsigned*)(F.lds + LDSCTL_OFF))[u] = 0u;
    __syncthreads();
    XcdBarrier bar; bar.bar = F.ctl + CW_BAR; bar.x = 0; bar.st = nullptr;
    if (N_LAUNCHES == 1) bar = xcd_barrier_post(F.ctl + CW_BAR, F.MISC + 8);
#define GRID_BAR() do { if (N_LAUNCHES == 1) xcd_barrier(bar); } while (0)
    const int lo = args.ph_lo, hi = args.ph_hi;
#ifndef PH_MASK
#define PH_MASK 0x7ff
#endif
#define IN(k) (((PH_MASK >> (k)) & 1) && lo <= (k) && (k) < hi)
#ifndef REP_MASK
#define REP_MASK 0
#endif
#ifndef MIX_VAR
#define MIX_VAR 0
#endif
#ifndef STAG_TICKS
#define STAG_TICKS 600
#endif
#ifndef STAG_NG
#define STAG_NG 4
#endif
#define REPS(k) _Pragma("unroll") for (int rep_ = 0; rep_ < 1 + ((REP_MASK >> (k)) & 1); ++rep_)
    const float* x = args.in[0]; const float* w_in = args.in[1]; const float* da_lambda = args.in[2]; const float* da_subln_w = args.in[3]; const float* w_da_out = args.in[4];
    const float* ret_gn_w = args.in[5]; const float* ret_gn_b = args.in[6]; const float* w_ret_out = args.in[7]; const float* w_out = args.in[8];
    const float* ln1_w = args.in[9]; const float* ln1_b = args.in[10]; const float* peer_wq = args.in[11]; const float* peer_keys = args.in[12];
    const float* peer_u = args.in[13]; const float* peer_v = args.in[14]; const float* ln2_w = args.in[15]; const float* ln2_b = args.in[16];
    bf16* KEYS = (bf16*)(ws + WS_KEYS); bf16* WDA = (bf16*)(ws + WS_WDA); bf16* WRET = (bf16*)(ws + WS_WRET); bf16* WOUT = (bf16*)(ws + WS_WOUT); bf16* WQ = (bf16*)(ws + WS_WQ);
    bf16* UB = (bf16*)(ws + WS_UB); bf16* VT = (bf16*)(ws + WS_VT); bf16* XB = (bf16*)(ws + WS_XB); bf16* WIN = (bf16*)(ws + WS_WIN); bf16* PROJ = (bf16*)(ws + WS_PROJ);
    unsigned char* ATTO = ws + WS_ATTO; unsigned char* RETO = ws + WS_RETO; bf16* MERGED = (bf16*)(ws + WS_MERGED); unsigned char* MERGED8 = ws + WS_MERGED8;
    unsigned char* U8 = ws + WS_UB; unsigned char* VT8 = ws + WS_VT; unsigned char* A8 = ws + WS_A8; unsigned char* X1F8 = ws + WS_X1F8;
    bf16* Z1 = (bf16*)(ws + WS_Z1); bf16* X1B = (bf16*)(ws + WS_X1B); bf16* QP = (bf16*)(ws + WS_QP); bf16* GM = (bf16*)(ws + WS_G);
    const int gw = F.vcu * NWAVES + F.wave, NGW = F.G * NWAVES;
    const size_t gt = (size_t)F.vcu * (NWAVES * 64) + F.tid, gs = (size_t)F.G * (NWAVES * 64);

    if (IN(0)) {
        LAS float* scr = (LAS float*)(F.lds + F.wave * 16384);
        constexpr int I_IN = (DM / 64) * (LDP / 32), I_DA = (2048 / 64) * (DM / 32), I_RET = (DM / 64) * (DM / 32), I_OUT = I_RET, I_Q = (DM / 64) * (2048 / 32), I_V = (NE / 64) * (DM / 32);
        constexpr int NITEMS = I_IN + I_DA + I_RET + I_OUT + I_Q + I_V;
        for (int it = gw; it < NITEMS; it += NGW) {
            int r = it;
#if FP6_P1
            if (r < I_IN) { p0_transpose_item_f6(w_in, DM, LDP, (unsigned char*)WIN, scr, r, F.lane, WIN6_SCALE); continue; } r -= I_IN;
#else
            if (r < I_IN) { const int n0 = 32 * (r % (LDP / 32)); const float sc = (n0 < 2048) ? 0.125f * LOG2E : ((n0 >= C_RK && n0 < C_RV) ? 0.08838834764831845f : 1.0f);
                            p0_transpose_item_f8(w_in, DM, LDP, (unsigned char*)WIN, scr, r, F.lane, sc * WIN_SCALE); continue; } r -= I_IN;
#endif
            if (r < I_DA) { p0_transpose_item_f8(w_da_out, 2048, DM, (unsigned char*)WDA, scr, r, F.lane, WDA_SCALE); continue; } r -= I_DA;
            if (r < I_RET) { p0_transpose_item_f8(w_ret_out, DM, DM, (unsigned char*)WRET, scr, r, F.lane, WRET_SCALE); continue; } r -= I_RET;
            if (r < I_OUT) { p0_transpose_item_f8(w_out, DM, DM, (unsigned char*)WOUT, scr, r, F.lane, WOUT_SCALE); continue; } r -= I_OUT;
            if (r < I_Q) { p0_transpose_item_f6(peer_wq, DM, 2048, (unsigned char*)WQ, scr, r, F.lane, WQ6_SCALE); continue; } r -= I_Q;
            p0_transpose_item_f8(peer_v, NE, DM, VT8, scr, r, F.lane, V_SCALE);
        }
#if FP6_P1
        cvt_flat_f6_lds(x, (unsigned char*)XB, MT * (DM / 2048), gw, NGW, F.lane, (LAS unsigned char*)scr, X_SCALE);
#else
        cvt_flat_f8(x, (unsigned char*)XB, (size_t)MT * DM / 16, gt, gs, 1.0f);
#endif
#if FP6_P8
        cvt_flat_f6_lds(peer_u, U8, NE * (DM / 2048), gw, NGW, F.lane, (LAS unsigned char*)scr, U6_SCALE);
#else
        cvt_flat_f8(peer_u, U8, (size_t)NE * DM / 16, gt, gs, U_SCALE);
#endif
        cvt_flat(peer_keys, KEYS, (size_t)8 * 2 * 128 * 128 / 8, gt, gs);
        GRID_BAR();
#if (REP_MASK & 1)
        scr = (LAS float*)(F.lds + F.wave * 16384);
        for (int it = gw; it < NITEMS; it += NGW) {
            int r = it;
#if FP6_P1
            if (r < I_IN) { p0_transpose_item_f6(w_in, DM, LDP, (unsigned char*)WIN, scr, r, F.lane, WIN6_SCALE); continue; } r -= I_IN;
#else
            if (r < I_IN) { const int n0 = 32 * (r % (LDP / 32)); const float sc = (n0 < 2048) ? 0.125f * LOG2E : ((n0 >= C_RK && n0 < C_RV) ? 0.08838834764831845f : 1.0f);
                            p0_transpose_item_f8(w_in, DM, LDP, (unsigned char*)WIN, scr, r, F.lane, sc * WIN_SCALE); continue; } r -= I_IN;
#endif
            if (r < I_DA) { p0_transpose_item_f8(w_da_out, 2048, DM, (unsigned char*)WDA, scr, r, F.lane, WDA_SCALE); continue; } r -= I_DA;
            if (r < I_RET) { p0_transpose_item_f8(w_ret_out, DM, DM, (unsigned char*)WRET, scr, r, F.lane, WRET_SCALE); continue; } r -= I_RET;
            if (r < I_OUT) { p0_transpose_item_f8(w_out, DM, DM, (unsigned char*)WOUT, scr, r, F.lane, WOUT_SCALE); continue; } r -= I_OUT;
            if (r < I_Q) { p0_transpose_item_f6(peer_wq, DM, 2048, (unsigned char*)WQ, scr, r, F.lane, WQ6_SCALE); continue; } r -= I_Q;
            p0_transpose_item_f8(peer_v, NE, DM, VT8, scr, r, F.lane, V_SCALE);
        }
#if FP6_P1
        cvt_flat_f6_lds(x, (unsigned char*)XB, MT * (DM / 2048), gw, NGW, F.lane, (LAS unsigned char*)scr, X_SCALE);
#else
        cvt_flat_f8(x, (unsigned char*)XB, (size_t)MT * DM / 16, gt, gs, 1.0f);
#endif
#if FP6_P8
        cvt_flat_f6_lds(peer_u, U8, NE * (DM / 2048), gw, NGW, F.lane, (LAS unsigned char*)scr, U6_SCALE);
#else
        cvt_flat_f8(peer_u, U8, (size_t)NE * DM / 16, gt, gs, U_SCALE);
#endif
        cvt_flat(peer_keys, KEYS, (size_t)8 * 2 * 128 * 128 / 8, gt, gs);
        GRID_BAR();
#endif
    }
    if (IN(1)) {
        pg8::Gemm g{XB, WIN, MT, LDP, DM / 2}; pg8::StaticOrder S; S.init(MT, LDP, F.G, (int)blockIdx.x);
#if FP6_P1
        constexpr float s1 = 1.0f / (X_SCALE * WIN6_SCALE);
        pg8::Epi8<pg8::OpStoreProj> E{{PROJ, (bf16*)(ws + WS_RQKV), s1}};
        pg8::gemm_phase<pg8::Epi8<pg8::OpStoreProj>, pg8::StaticOrder, true, true, 2>(F.lds, g, S, E);
#else
        pg8::Epi8<pg8::OpStoreS> E{{PROJ, LDP, 1.0f / WIN_SCALE}};
        pg8::gemm_phase<pg8::Epi8<pg8::OpStoreS>, pg8::StaticOrder, true, true, 1>(F.lds, g, S, E);
#endif
        GRID_BAR();
    }
#if (REP_MASK & 0x2)
    if (IN(1)) {
        pg8::Gemm g{XB, WIN, MT, LDP, DM / 2}; pg8::StaticOrder S; S.init(MT, LDP, F.G, (int)blockIdx.x);
        pg8::Epi8<pg8::OpStoreProj> E{{PROJ, (bf16*)(ws + WS_RQKV), 1.0f / (X_SCALE * WIN6_SCALE)}};
        pg8::gemm_phase<pg8::Epi8<pg8::OpStoreProj>, pg8::StaticOrder, true, true, 2>(F.lds, g, S, E);
        GRID_BAR();
    }
#endif
    if (IN(2)) {
        const mix::MixArgs A{PROJ, ATTO, RETO, (bf16*)(ws + WS_STATE), da_lambda, da_subln_w, ret_gn_w, ret_gn_b};
#if (REP_MASK & 0x100000)
        { int nrep = 4; asm volatile("" : "+s"(nrep));
          for (int rep = 0; rep < nrep; ++rep) { for (int u = F.vcu; u < 256; u += F.G) mix::ret_fused_unit<PROBE_ABL>(F.lds, A, (const bf16*)(ws + WS_RQKV), (bf16*)(ws + WS_STATE), (float*)(ws + WS_RSTATS), u >> 5, (u >> 1) & 15, u & 1);
          __syncthreads(); }
          GRID_BAR(); }
#endif
#if RET_FUSED
        { bf16* RAW = (bf16*)(ws + WS_STATE); float* STATS = (float*)(ws + WS_RSTATS);
          for (int u = F.vcu; u < 256; u += F.G) mix::ret_fused_unit(F.lds, A, (const bf16*)(ws + WS_RQKV), RAW, STATS, u >> 5, (u >> 1) & 15, u & 1);
          for (int u = F.vcu; u < 512; u += F.G) {
              const int bh = u >> 2, j = u & 3;
              mix::attn_unit(F.lds, A, bh >> 4, bh & 15, j);
              mix::attn_unit(F.lds, A, bh >> 4, bh & 15, 7 - j);
          }
          GRID_BAR();
          for (int m = gw; m < MT; m += NGW) mix::ret_norm_row(A, RAW, STATS, (size_t)m, F.lane);
          GRID_BAR();
#if (REP_MASK & 0x200000)
          for (int m = gw; m < MT; m += NGW) mix::ret_norm_row(A, RAW, STATS, (size_t)m, F.lane);
          GRID_BAR();
#endif
          }
#else
        for (int u = F.vcu; u < 256; u += F.G) mix::ret_state_unit(F.lds, A, u >> 5, (u >> 1) & 15, u & 1);
        GRID_BAR();
        for (int u = F.vcu; u < 2048; u += F.G) mix::ret_unit(F.lds, A, u >> 8, (u >> 4) & 15, u & 15);
        GRID_BAR();
#endif
    }
#if (REP_MASK & 0x4)
    if (IN(2)) {
        const mix::MixArgs A{PROJ, (MIX_VAR ? X1F8 : ATTO), RETO, (bf16*)(ws + WS_STATE), da_lambda, da_subln_w, ret_gn_w, ret_gn_b};
        if (!(REP_MASK & 0x8000)) for (int u = F.vcu; u < 512; u += F.G) {
            const int bh = u >> 2, j = u & 3;
            mix::attn_unit<MIX_VAR>(F.lds, A, bh >> 4, bh & 15, j);
            mix::attn_unit<MIX_VAR>(F.lds, A, bh >> 4, bh & 15, 7 - j);
        }
        if (!(REP_MASK & 0x4000)) for (int u = F.vcu; u < 256; u += F.G) mix::ret_state_unit(F.lds, A, u >> 5, (u >> 1) & 15, u & 1);
        GRID_BAR();
        if (!(REP_MASK & 0x4000)) for (int u = F.vcu; u < 2048; u += F.G) mix::ret_unit(F.lds, A, u >> 8, (u >> 4) & 15, u & 15);
        GRID_BAR();
    }
#endif
    if (IN(3)) {
#ifndef P3_ONLY_R
        { pg8::Gemm g{(const bf16*)ATTO, WDA, MT, DM, 2048 / 2}; pg8::StaticOrder S; S.init(MT, DM, F.G, (int)blockIdx.x);
          pg8::Epi8<pg8::OpGateA> E{{PROJ, MERGED, 1.0f / (mix::ATT_SCALE * WDA_SCALE)}};
          pg8::gemm_phase<pg8::Epi8<pg8::OpGateA>, pg8::StaticOrder, true, true, 1>(F.lds, g, S, E); }
#endif
        __syncthreads();
#ifndef P3_ONLY_A
        { pg8::Gemm g{(const bf16*)RETO, WRET, MT, DM, DM / 2}; pg8::StaticOrder S; S.init(MT, DM, F.G, (int)blockIdx.x);
          pg8::Epi8<pg8::OpGateR> E{{PROJ, MERGED, MERGED8, 1.0f / (mix::RET_SCALE * WRET_SCALE), M_SCALE}};
          pg8::gemm_phase<pg8::Epi8<pg8::OpGateR>, pg8::StaticOrder, true, true, 1>(F.lds, g, S, E); }
#endif
        GRID_BAR();
    }
#if (REP_MASK & 0x8)
    if (IN(3)) {
        { pg8::Gemm g{(const bf16*)ATTO, WDA, MT, DM, 2048 / 2}; pg8::StaticOrder S; S.init(MT, DM, F.G, (int)blockIdx.x);
          pg8::Epi8<pg8::OpGateA> E{{PROJ, MERGED, 1.0f / (mix::ATT_SCALE * WDA_SCALE)}};
          pg8::gemm_phase<pg8::Epi8<pg8::OpGateA>, pg8::StaticOrder, true, true, 1>(F.lds, g, S, E); }
        __syncthreads();
        { pg8::Gemm g{(const bf16*)RETO, WRET, MT, DM, DM / 2}; pg8::StaticOrder S; S.init(MT, DM, F.G, (int)blockIdx.x);
          pg8::Epi8<pg8::OpGateR> E{{PROJ, MERGED, MERGED8, 1.0f / (mix::RET_SCALE * WRET_SCALE), M_SCALE}};
          pg8::gemm_phase<pg8::Epi8<pg8::OpGateR>, pg8::StaticOrder, true, true, 1>(F.lds, g, S, E); }
        GRID_BAR();
    }
#endif
    if (IN(4)) {
        pg8::Gemm g{(const bf16*)MERGED8, WOUT, MT, DM, DM / 2}; pg8::StaticOrder S; S.init(MT, DM, F.G, (int)blockIdx.x);
        pg8::Epi8<pg8::OpResF32> E{{x, Z1, 1.0f / (M_SCALE * WOUT_SCALE)}};
        pg8::gemm_phase<pg8::Epi8<pg8::OpResF32>, pg8::StaticOrder, true, true, 1>(F.lds, g, S, E);
        GRID_BAR();
    }
#if (REP_MASK & 0x10)
    if (IN(4)) {
        pg8::Gemm g{(const bf16*)MERGED8, WOUT, MT, DM, DM / 2}; pg8::StaticOrder S; S.init(MT, DM, F.G, (int)blockIdx.x);
#if (REP_MASK & 0x10000)
        pg8::Epi8<pg8::OpNull> E{{Z1}};
        pg8::gemm_phase<pg8::Epi8<pg8::OpNull>, pg8::StaticOrder, true, true, 1>(F.lds, g, S, E);
#elif (REP_MASK & 0x20000)
        pg8::Epi8<pg8::OpResF32NoStore> E{{x, (bf16*)X1F8, 1.0f}};
        pg8::gemm_phase<pg8::Epi8<pg8::OpResF32NoStore>, pg8::StaticOrder, true, true, 1>(F.lds, g, S, E);
#elif (REP_MASK & 0x40000)
        pg8::Epi8<pg8::OpResF32NoLoad> E{{x, (bf16*)(ws + WS_STATE), 1.0f}};
        pg8::gemm_phase<pg8::Epi8<pg8::OpResF32NoLoad>, pg8::StaticOrder, true, true, 1>(F.lds, g, S, E);
#else
        pg8::Epi8<pg8::OpResF32> E{{x, Z1, 1.0f / (M_SCALE * WOUT_SCALE)}};
        pg8::gemm_phase<pg8::Epi8<pg8::OpResF32>, pg8::StaticOrder, true, true, 1>(F.lds, g, S, E);
#endif
        GRID_BAR();
    }
#endif
    if (IN(5)) {
        for (int m = gw; m < MT; m += NGW) ln_row<false>(Z1 + (size_t)m * LDZ, ln1_w, ln1_b, X1B + (size_t)m * DM, X1F8 + (size_t)m * DM, F.lane, F.lds + F.wave * 16384);
        GRID_BAR();
    }
#if (REP_MASK & 0x800)
    if (IN(5)) {
        for (int m = gw; m < MT; m += NGW) ln_row<false>(Z1 + (size_t)m * LDZ, ln1_w, ln1_b, X1B + (size_t)m * DM, X1F8 + (size_t)m * DM, F.lane, F.lds + F.wave * 16384);
        GRID_BAR();
    }
#endif
    if (IN(6)) {
        pg8::Gemm g{(const bf16*)X1F8, WQ, MT, 2048, DM / 2}; pg8::StaticOrder S; S.init(MT, 2048, F.G, (int)blockIdx.x);
        pg8::Epi8<pg8::OpStoreS> E{{QP, 2048, 1.0f / (X1_SCALE * WQ6_SCALE)}};
        pg8::gemm_phase<pg8::Epi8<pg8::OpStoreS>, pg8::StaticOrder, true, true, 2>(F.lds, g, S, E);
        GRID_BAR();
    }
    if (IN(7)) {
        for (int g = F.vcu; g < MT / 32; g += F.G) {
            peer::topk_item(QP, KEYS, (LAS unsigned*)F.lds, g, F.wave);
            __syncthreads();
            peer::topk_store_dense((const LAS unsigned*)F.lds, F.lds + 32768, (unsigned char*)GM, g);
        }
        GRID_BAR();
    }
#if (REP_MASK & 0x400)
    if (IN(7)) {
        for (int g = F.vcu; g < MT / 32; g += F.G) {
            peer::topk_item(QP, KEYS, (LAS unsigned*)F.lds, g, F.wave);
            __syncthreads();
            peer::topk_store_dense((const LAS unsigned*)F.lds, F.lds + 32768, (unsigned char*)GM, g);
        }
        GRID_BAR();
    }
#endif
#if (REP_MASK & 0x20)
    if (IN(5) && (REP_MASK & 0x20)) {
        for (int m = gw; m < MT; m += NGW) ln_row<false>(Z1 + (size_t)m * LDZ, ln1_w, ln1_b, X1B + (size_t)m * DM, X1F8 + (size_t)m * DM, F.lane, F.lds + F.wave * 16384);
        GRID_BAR();
    }
    if (IN(6) && (REP_MASK & 0x20)) {
        pg8::Gemm g{X1B, WQ, MT, 2048, DM}; pg8::StaticOrder S; S.init(MT, 2048, F.G, (int)blockIdx.x);
        pg8::Epi8<pg8::OpStore> E{{QP, 2048}};
        pg8::gemm_phase<pg8::Epi8<pg8::OpStore>, pg8::StaticOrder, true, true>(F.lds, g, S, E);
        GRID_BAR();
    }
    if (IN(7) && (REP_MASK & 0x20)) {
        for (int g = F.vcu; g < MT / 32; g += F.G) {
            peer::topk_item(QP, KEYS, (LAS unsigned*)F.lds, g, F.wave);
            __syncthreads();
            peer::topk_store((const LAS unsigned*)F.lds, (unsigned char*)GM, g);
            __syncthreads();
        }
        GRID_BAR();
    }
#endif
    if (IN(8)) {
        pg8::Gemm g{(const bf16*)X1F8, (const bf16*)U8, MT, NE, DM / 2}; pg8::StaticOrder S; S.init(MT, NE, F.G, (int)blockIdx.x);
#if FP6_P8
        pg8::Epi8<pg8::OpPeerH8> E{{(unsigned char*)GM, 1.0f / (X1_SCALE * U6_SCALE)}};
        pg8::gemm_phase<pg8::Epi8<pg8::OpPeerH8>, pg8::StaticOrder, true, true, 2>(F.lds, g, S, E);
#else
        pg8::Epi8<pg8::OpPeerH8> E{{(unsigned char*)GM, 1.0f / U_SCALE}};
        pg8::gemm_phase<pg8::Epi8<pg8::OpPeerH8>, pg8::StaticOrder, true, true, 1>(F.lds, g, S, E);
#endif
        GRID_BAR();
    }
#if (REP_MASK & 0x100)
    if (IN(8)) {
        pg8::Gemm g{(const bf16*)X1F8, (const bf16*)U8, MT, NE, DM / 2}; pg8::StaticOrder S; S.init(MT, NE, F.G, (int)blockIdx.x);
#if (REP_MASK & 0x10000)
        pg8::Epi8<pg8::OpNull> E{{Z1}};
        pg8::gemm_phase<pg8::Epi8<pg8::OpNull>, pg8::StaticOrder, true, true, 2>(F.lds, g, S, E);
#elif (REP_MASK & 0x20000)
        pg8::Epi8<pg8::OpPeerH8Probe<true>> E{{(const unsigned char*)GM, ws + WS_A8, 1.0f / (X1_SCALE * U6_SCALE)}};
        pg8::gemm_phase<pg8::Epi8<pg8::OpPeerH8Probe<true>>, pg8::StaticOrder, true, true, 2>(F.lds, g, S, E);
#else
        pg8::Epi8<pg8::OpPeerH8Probe<false>> E{{(const unsigned char*)GM, ws + WS_A8, 1.0f / (X1_SCALE * U6_SCALE)}};
        pg8::gemm_phase<pg8::Epi8<pg8::OpPeerH8Probe<false>>, pg8::StaticOrder, true, true, 2>(F.lds, g, S, E);
#endif
        GRID_BAR();
    }
#endif
    if (IN(9)) {
        pg8::Gemm g{(const bf16*)GM, (const bf16*)VT8, MT, DM, NE / 2}; pg8::StaticOrder S; S.init(MT, DM, F.G, (int)blockIdx.x);
        pg8::Epi8<pg8::OpResBfS> E{{X1B, Z1, 1.0f / (A_SCALE * V_SCALE)}};
        pg8::gemm_phase<pg8::Epi8<pg8::OpResBfS>, pg8::StaticOrder, true, true, 1>(F.lds, g, S, E);
        GRID_BAR();
    }
#if (REP_MASK & 0x200)
    if (IN(9)) {
        pg8::Gemm g{(const bf16*)GM, (const bf16*)VT8, MT, DM, NE / 2}; pg8::StaticOrder S; S.init(MT, DM, F.G, (int)blockIdx.x);
        pg8::Epi8<pg8::OpResBfS> E{{X1B, Z1, 1.0f / (A_SCALE * V_SCALE)}};
        pg8::gemm_phase<pg8::Epi8<pg8::OpResBfS>, pg8::StaticOrder, true, true, 1>(F.lds, g, S, E);
        GRID_BAR();
    }
#endif
    if (IN(10)) {
        for (int m = gw; m < MT; m += NGW) ln_row<true>(Z1 + (size_t)m * LDZ, ln2_w, ln2_b, args.out + (size_t)m * DM, nullptr, F.lane, F.lds + F.wave * 16384);
    }
#if (REP_MASK & 0x1000)
    GRID_BAR();
    if (IN(10)) {
        for (int m = gw; m < MT; m += NGW) ln_row<true>(Z1 + (size_t)m * LDZ, ln2_w, ln2_b, args.out + (size_t)m * DM, nullptr, F.lane, F.lds + F.wave * 16384);
    }
#endif
#undef IN
#undef GRID_BAR
}

extern "C" void kernel_launch(void* const* d_in, const int* in_sizes, int n_in, void* d_out, int out_size, void* d_ws, size_t ws_size, hipStream_t stream) {
    static int grid = 0;
    if (grid == 0) {
        if (n_in != 17 || in_sizes[0] != MT * DM || out_size != MT * DM || ws_size < WS_END) { fprintf(stderr, "kernel_launch: unexpected shapes (n_in %d, ws %zu)\n", n_in, ws_size); grid = -1; return; }
        int dev = 0, cus = 0, per_cu = 0;
        if (hipGetDevice(&dev) != hipSuccess || hipDeviceGetAttribute(&cus, hipDeviceAttributeMultiprocessorCount, dev) != hipSuccess) { grid = -1; return; }
        if (hipFuncSetAttribute((const void*)mk_fwd, hipFuncAttributeMaxDynamicSharedMemorySize, LDS_BYTES) != hipSuccess) { grid = -1; return; }
        if (hipOccupancyMaxActiveBlocksPerMultiprocessor(&per_cu, (const void*)mk_fwd, NWAVES * 64, LDS_BYTES) != hipSuccess || per_cu < 1) { fprintf(stderr, "kernel_launch: occupancy query says %d\n", per_cu); }
        (void)hipGetLastError();
        grid = cus;
    }
    if (grid < 0) return;
    if (hipMemsetAsync((char*)d_ws + WS_CTL, 0, CTL_ZERO_BYTES, stream) != hipSuccess) return;
    Args a{};
    for (int i = 0; i < 17; ++i) a.in[i] = (const float*)d_in[i];
    a.out = (float*)d_out; a.ws = (unsigned char*)d_ws;
    for (int li = 0; li < N_LAUNCHES; ++li) {
        a.ph_lo = (N_LAUNCHES == 1) ? 0 : li; a.ph_hi = (N_LAUNCHES == 1) ? N_PHASES : li + 1; a.li = li; a.pad = 0;
        hipLaunchKernelGGL(mk_fwd, dim3(grid), dim3(NWAVES * 64), LDS_BYTES, stream, a);
    }
}
```

```cpp
#include <cstdio>
#include <cstdint>
#include <cmath>
#include <hip/hip_runtime.h>
#include <cstdio>
#include <cstdint>
namespace pg8 {
#define PG8_LAS __attribute__((address_space(3)))
typedef unsigned short bf16_t;
typedef short bf16x8 __attribute__((ext_vector_type(8)));
typedef float f32x4 __attribute__((ext_vector_type(4)));
typedef unsigned u32x4 __attribute__((ext_vector_type(4)));
constexpr int BM = 256, BK = 64, HALF = 128, HTB = HALF * BK * 2  , STAGE_BYTES = 8 * HTB, NXCD = 8, WGM = 8;

__host__ __device__ __forceinline__ int lds_byte(int r, int c) { const int st = (r >> 4) * 2 + (c >> 5), rr = r & 15, cc = c & 31, ob = rr * 64 + cc * 2; return st * 1024 + (ob ^ (((ob >> 9) & 1) << 5)); }
__host__ __device__ __forceinline__ void stage_rc(int b, int& R, int& C) { const int st = b / 1024, sb = b % 1024, swz = sb ^ (((sb >> 9) & 1) << 5); R = (st >> 1) * 16 + swz / 64; C = (st & 1) * 32 + (swz % 64) / 2; }
__host__ __device__ __forceinline__ int perm32(int rho) { const int n = rho >> 4, i = rho & 15; return 8 * (i >> 2) + 4 * n + (i & 3); }

struct Unit { int pm, pn; };
struct Gemm { const bf16_t* A; const bf16_t* Bt; int M, N, K; int kmul = 1;   };

struct StaticOrder {
    int nM, nN, nwg, G, c;
    __host__ __device__ void init(int M, int N, int G_, int c_) { nM = M / BM; nN = N / BM; nwg = nM * nN; G = G_; c = c_; }
    __host__ __device__ bool next(int i, Unit& u) const {
        const long L = (long)i * G + c; if (L >= nwg) return false;
        int wgid = (int)L; { const int q = nwg / NXCD, r = nwg % NXCD, xcd = wgid % NXCD, off = wgid / NXCD; wgid = (xcd < r ? xcd * (q + 1) : r * (q + 1) + (xcd - r) * q) + off; }
        const int nig = WGM * nN, gid = wgid / nig, fm = gid * WGM, gsz = (nM - fm) < WGM ? (nM - fm) : WGM;
        u.pm = fm + ((wgid % nig) % gsz); u.pn = (wgid % nig) / gsz; return true;
    }
    __device__ __forceinline__ void a_ready(const Unit&) const {}
    __device__ __forceinline__ void done(const Unit&) const {}
};

__device__ __forceinline__ unsigned cvt_pk_bf16(float lo, float hi) { unsigned r; asm volatile("v_cvt_pk_bf16_f32 %0, %1, %2" : "=v"(r) : "v"(lo), "v"(hi)); return r; }
typedef float f32x2 __attribute__((ext_vector_type(2)));
__device__ __forceinline__ f32x2 gelu_pk(f32x2 v) {
    const f32x2 av = __builtin_elementwise_abs(v), d = av * 0.2316418882f + 1.0f;
    f32x2 t; t.x = __builtin_amdgcn_rcpf(d.x); t.y = __builtin_amdgcn_rcpf(d.y);
    f32x2 q = t * 0.5307027145f + (-0.7265760135f); q = q * t + 0.7107068705f; q = q * t + (-0.142248368f); q = q * t + 0.127414796f; q = q * t;
    const f32x2 s = (v * v) * (-0.72134752044f);
    f32x2 e; e.x = __builtin_amdgcn_exp2f(s.x); e.y = __builtin_amdgcn_exp2f(s.y);
    const f32x2 m = v * (q * e), r = v - m;
    f32x2 o; o.x = v.x < 0.f ? m.x : r.x; o.y = v.y < 0.f ? m.y : r.y; return o;
}

template <int ACT  > struct EpiBf16 {
    static constexpr bool PERM = true, AFTER_DRAIN = false; static_assert(ACT == 0 || ACT == 1, "EpiBf16: ACT is 0 (none) or 1 (gelu_pk)");
    bf16_t* O; int ldc; const float* bias; int split_cols; size_t split_stride; float scale0;
    __device__ __forceinline__ void operator()(const f32x4 (&acc)[2][2][4][2], const Unit& u, int wr, int wc, int fr, int fq) const {
        const int row0 = u.pm * BM + wr * 64 + fr; int colt = u.pn * BM; bf16_t* base = O;
        float sc = 1.f; if (split_cols) { const int t = colt / split_cols; base += (size_t)t * split_stride; colt -= t * split_cols; if (t == 0) sc = scale0; }
        const int col0 = colt + wc * 32 + 8 * fq, bcol0 = u.pn * BM + wc * 32 + 8 * fq;
        f32x4 bv[2][2];
#pragma unroll
        for (int bj = 0; bj < 2; ++bj)
#pragma unroll
            for (int n = 0; n < 2; ++n) bv[bj][n] = bias ? *(const f32x4*)(bias + bcol0 + bj * HALF + 4 * n) : (f32x4){0.f, 0.f, 0.f, 0.f};
#pragma unroll
        for (int ai = 0; ai < 2; ++ai)
#pragma unroll
            for (int m = 0; m < 4; ++m) { bf16_t* rowp = base + (size_t)(row0 + ai * HALF + m * 16) * ldc + col0;
#pragma unroll
                for (int bj = 0; bj < 2; ++bj) { f32x4 v0 = acc[ai][bj][m][0] + bv[bj][0], v1 = acc[ai][bj][m][1] + bv[bj][1];
                    if (ACT == 1) { f32x2 a = gelu_pk((f32x2){v0[0], v0[1]}), b = gelu_pk((f32x2){v0[2], v0[3]}), c = gelu_pk((f32x2){v1[0], v1[1]}), d = gelu_pk((f32x2){v1[2], v1[3]});
                        v0 = (f32x4){a.x, a.y, b.x, b.y}; v1 = (f32x4){c.x, c.y, d.x, d.y}; }
                    v0 = v0 * sc; v1 = v1 * sc; u32x4 w; w.x = cvt_pk_bf16(v0[0], v0[1]); w.y = cvt_pk_bf16(v0[2], v0[3]); w.z = cvt_pk_bf16(v1[0], v1[1]); w.w = cvt_pk_bf16(v1[2], v1[3]);
                    *(u32x4*)(rowp + bj * HALF) = w; } }
    }
};
typedef int v8i32_t __attribute__((ext_vector_type(8))); typedef int v6i32_t __attribute__((ext_vector_type(6))); typedef int v4i32_t __attribute__((ext_vector_type(4)));
__device__ __forceinline__ v6i32_t six(v8i32_t v) { return __builtin_shufflevector(v, v, 0, 1, 2, 3, 4, 5); }
__device__ __forceinline__ bf16x8 lo8(v8i32_t v) { return __builtin_bit_cast(bf16x8, __builtin_shufflevector(v, v, 0, 1, 2, 3)); }
__device__ __forceinline__ bf16x8 hi8(v8i32_t v) { return __builtin_bit_cast(bf16x8, __builtin_shufflevector(v, v, 4, 5, 6, 7)); }
__device__ __forceinline__ v8i32_t cat8(bf16x8 a, bf16x8 b) { const v4i32_t x = __builtin_bit_cast(v4i32_t, a), y = __builtin_bit_cast(v4i32_t, b); return (v8i32_t){x[0], x[1], x[2], x[3], y[0], y[1], y[2], y[3]}; }
typedef int v2i32_t __attribute__((ext_vector_type(2)));
template <int F> struct FragT { typedef v8i32_t type; };

template <int F> __device__ __forceinline__ v8i32_t ldfrag(const PG8_LAS unsigned char* p) {
    const v4i32_t x = *(const PG8_LAS v4i32_t*)p; const v4i32_t y = *(const PG8_LAS v4i32_t*)(p + 1024);
    v8i32_t r = (v8i32_t){x[0], x[1], x[2], x[3], y[0], y[1], y[2], y[3]};
    return r;
}
template <class Epi, class Sched, bool ALIGN_EPI = false, bool SP2 = false, int FP8 = 0  >
__device__ __forceinline__ void gemm_phase(PG8_LAS unsigned char* lds, const Gemm g, const Sched& S, const Epi& E) {
    const int tid = threadIdx.x, wid = __builtin_amdgcn_readfirstlane(tid >> 6), lane = tid & 63, wr = wid >> 2, wc = wid & 3, fr = lane & 15, fq = lane >> 4;
    const int K = g.K, nt = K / BK;
    unsigned voffA[2], voffB[2];
#pragma unroll
    for (int i = 0; i < 2; ++i) { int R, C; stage_rc(tid * 16 + i * 8192, R, C); const int Rb = Epi::PERM ? ((R & ~31) + perm32(R & 31)) : R;
        if constexpr (FP8 == 2) { const int p = C >> 3; C = 8 * ((p < 4) ? 2 * p : 2 * (p - 4) + 1); }
        voffA[i] = (unsigned)(R * K + C) * 2u; voffB[i] = (unsigned)(Rb * K + C) * 2u; }
    const size_t kstep = (size_t)(BK * 2) * (size_t)g.kmul;
    const size_t hstep = (size_t)HALF * K * 2;
    const size_t tstep = 2 * hstep;
    const unsigned ldsw = (unsigned)wid * 1024u;
    const int aoff = lds_byte(wr * 64 + fr, fq * 8), boff = lds_byte(wc * 32 + fr, fq * 8);
#define PG8_SA(b, h) (((b) * 2 + (h)) * HTB)
#define PG8_SB(b, h) ((4 + (b) * 2 + (h)) * HTB)
#define PG8_STAGE(bufoff, gbase, voff) do { _Pragma("unroll") for (int _i = 0; _i < 2; ++_i) \
        __builtin_amdgcn_global_load_lds((const unsigned*)((const char*)(gbase) + (voff)[_i]), (PG8_LAS unsigned*)(lds + (bufoff) + ldsw + _i * 8192), 16, 0, 0); } while (0)
#define PG8_LDA(dst, b, h) do { _Pragma("unroll") for (int m = 0; m < 4; ++m) dst[m] = ldfrag<FP8>(lds + PG8_SA(b, h) + aoff + m * 2048); } while (0)
#define PG8_LDB(dst, b, h) do { _Pragma("unroll") for (int n = 0; n < 2; ++n) dst[n] = ldfrag<FP8>(lds + PG8_SB(b, h) + boff + n * 2048); } while (0)
#define PG8_MMA(ai, bj, At, Bt) do { if constexpr (FP8 == 2) { asm volatile("" : "+v"(At[0]), "+v"(At[1]), "+v"(At[2]), "+v"(At[3]), "+v"(Bt[0]), "+v"(Bt[1])); }     \
        __builtin_amdgcn_s_setprio(1); _Pragma("unroll") for (int m = 0; m < 4; ++m) _Pragma("unroll") for (int n = 0; n < 2; ++n) { \
        if constexpr (FP8 == 1) { asm volatile("s_nop 1\n\tv_mfma_scale_f32_16x16x128_f8f6f4 %0, %1, %2, %0, %3, %3 op_sel_hi:[0,0,0]" : "+v"(acc[ai][bj][m][n]) : "v"(Bt[n]), "v"(At[m]), "v"(f8scale)); } \
        else if constexpr (FP8 == 2) { asm volatile("s_nop 1\n\tv_mfma_scale_f32_16x16x128_f8f6f4 %0, %1, %2, %0, %3, %3 op_sel_hi:[0,0,0] cbsz:2 blgp:2" : "+v"(acc[ai][bj][m][n]) : "v"(six(Bt[n])), "v"(six(At[m])), "v"(f8scale)); } \
        else { acc[ai][bj][m][n] = __builtin_amdgcn_mfma_f32_16x16x32_bf16(lo8(Bt[n]), lo8(At[m]), acc[ai][bj][m][n], 0, 0, 0); \
               acc[ai][bj][m][n] = __builtin_amdgcn_mfma_f32_16x16x32_bf16(hi8(Bt[n]), hi8(At[m]), acc[ai][bj][m][n], 0, 0, 0); } } \
        __builtin_amdgcn_s_setprio(0); } while (0)
#define PG8_WAIT_V(n) asm volatile("s_waitcnt vmcnt(" #n ")" ::: "memory")
#define PG8_WAIT_V8F() do { if (fresh) asm volatile("s_waitcnt vmcnt(%0)" :: "n"(8 + Epi::NVM) : "memory"); else asm volatile("s_waitcnt vmcnt(8)" ::: "memory"); } while (0)
#define PG8_WAIT_L(n) asm volatile("s_waitcnt lgkmcnt(" #n ")" ::: "memory")
#define PG8_BAR __builtin_amdgcn_s_barrier()
#define PG8_SCHED __builtin_amdgcn_sched_barrier(0)
    Unit cur, nxt; int ui = 0;
    if (!S.next(0, cur)) return;
    f32x4 acc[2][2][4][2];
#pragma unroll
    for (int a = 0; a < 2; ++a)
#pragma unroll
        for (int b = 0; b < 2; ++b)
#pragma unroll
            for (int m = 0; m < 4; ++m)
#pragma unroll
                for (int n = 0; n < 2; ++n) acc[a][b][m][n] = (f32x4){0.f, 0.f, 0.f, 0.f};
    const int f8scale = 0x7f7f7f7f;
    typedef typename FragT<FP8>::type frag_t;
    frag_t At[4], B0[2], B1[2];
    const char* cA = (const char*)g.A + (size_t)cur.pm * tstep; const char* cB = (const char*)g.Bt + (size_t)cur.pn * tstep;
    S.a_ready(cur);
    if constexpr (SP2) {
        PG8_STAGE(PG8_SB(0, 0), cB, voffB); PG8_STAGE(PG8_SB(0, 1), cB + hstep, voffB); PG8_STAGE(PG8_SA(0, 0), cA, voffA); PG8_STAGE(PG8_SA(0, 1), cA + hstep, voffA);
        if (wr == 1) PG8_BAR;
        PG8_WAIT_V(2); PG8_BAR;
        PG8_STAGE(PG8_SB(1, 0), cB + kstep, voffB); PG8_STAGE(PG8_SA(1, 0), cA + kstep, voffA); PG8_STAGE(PG8_SB(1, 1), cB + hstep + kstep, voffB);
        PG8_WAIT_V(6); PG8_BAR;
    } else {
        PG8_STAGE(PG8_SB(0, 0), cB, voffB); PG8_STAGE(PG8_SA(0, 0), cA, voffA); PG8_STAGE(PG8_SB(0, 1), cB + hstep, voffB); PG8_STAGE(PG8_SA(0, 1), cA + hstep, voffA);
        if (wr == 1) PG8_BAR;
        PG8_WAIT_V(4); PG8_BAR;
        PG8_STAGE(PG8_SB(1, 0), cB + kstep, voffB); PG8_STAGE(PG8_SA(1, 0), cA + kstep, voffA); PG8_STAGE(PG8_SB(1, 1), cB + hstep + kstep, voffB);
        PG8_WAIT_V(6); PG8_BAR;
    }
    for (;;) {
        const bool has_next = S.next(ui + 1, nxt);
        const char* nA = has_next ? (const char*)g.A + (size_t)nxt.pm * tstep : cA; const char* nB = has_next ? (const char*)g.Bt + (size_t)nxt.pn * tstep : cB;
        for (int t = 0; t < nt; t += 2) {
            const bool last = (t == nt - 2); const bool fresh = (FP8 != 0) && (t == 0) && (ui > 0) && (Epi::NVM > 0);
            const char* a1 = cA + (size_t)(t + 1) * kstep;
            const char* a2 = last ? nA : cA + (size_t)(t + 2) * kstep; const char* b2 = last ? nB : cB + (size_t)(t + 2) * kstep;
            const char* a3 = a2 + kstep; const char* b3 = b2 + kstep;
            if (last && has_next) S.a_ready(nxt);
            if constexpr (SP2) {
            PG8_LDB(B0, 0, 0); PG8_LDB(B1, 0, 1); PG8_SCHED; PG8_LDA(At, 0, 0); PG8_STAGE(PG8_SA(1, 1), a1 + hstep, voffA);
            PG8_WAIT_V8F(); PG8_WAIT_L(0); PG8_BAR; PG8_MMA(0, 0, At, B0); PG8_MMA(0, 1, At, B1); PG8_BAR; PG8_SCHED;
            PG8_LDA(At, 0, 1); PG8_STAGE(PG8_SB(0, 0), b2, voffB); PG8_STAGE(PG8_SB(0, 1), b2 + hstep, voffB); PG8_STAGE(PG8_SA(0, 0), a2, voffA);
            PG8_WAIT_V8F(); PG8_WAIT_L(0); PG8_BAR; PG8_MMA(1, 0, At, B0); PG8_MMA(1, 1, At, B1); PG8_BAR; PG8_SCHED;
            PG8_LDB(B0, 1, 0); PG8_LDB(B1, 1, 1); PG8_SCHED; PG8_LDA(At, 1, 0); PG8_STAGE(PG8_SA(0, 1), a2 + hstep, voffA);
            PG8_WAIT_V(8); PG8_WAIT_L(0); PG8_BAR; PG8_MMA(0, 0, At, B0); PG8_MMA(0, 1, At, B1); PG8_BAR; PG8_SCHED;
            PG8_LDA(At, 1, 1); PG8_STAGE(PG8_SB(1, 0), b3, voffB); PG8_STAGE(PG8_SB(1, 1), b3 + hstep, voffB); PG8_STAGE(PG8_SA(1, 0), a3, voffA);
            PG8_WAIT_V(8); PG8_WAIT_L(0); PG8_BAR; PG8_MMA(1, 0, At, B0); PG8_MMA(1, 1, At, B1); PG8_BAR; PG8_SCHED;
            } else {
            PG8_LDB(B0, 0, 0); PG8_SCHED; PG8_LDA(At, 0, 0); PG8_STAGE(PG8_SA(1, 1), a1 + hstep, voffA);
            PG8_WAIT_L(8); PG8_BAR; PG8_WAIT_L(0); PG8_MMA(0, 0, At, B0); PG8_BAR; PG8_SCHED;
            PG8_LDB(B1, 0, 1); PG8_STAGE(PG8_SB(0, 0), b2, voffB);
            PG8_BAR; PG8_WAIT_L(0); PG8_MMA(0, 1, At, B1); PG8_BAR;
            PG8_LDA(At, 0, 1); PG8_STAGE(PG8_SA(0, 0), a2, voffA);
            PG8_BAR; PG8_WAIT_L(0); PG8_MMA(1, 0, At, B0); PG8_BAR; PG8_SCHED;
            PG8_STAGE(PG8_SB(0, 1), b2 + hstep, voffB);
            PG8_WAIT_V(6); PG8_BAR; PG8_MMA(1, 1, At, B1); PG8_BAR;
            PG8_LDB(B0, 1, 0); PG8_SCHED; PG8_LDA(At, 1, 0); PG8_STAGE(PG8_SA(0, 1), a2 + hstep, voffA);
            PG8_WAIT_L(8); PG8_BAR; PG8_WAIT_L(0); PG8_MMA(0, 0, At, B0); PG8_BAR; PG8_SCHED;
            PG8_LDB(B1, 1, 1); PG8_STAGE(PG8_SB(1, 0), b3, voffB);
            PG8_BAR; PG8_WAIT_L(0); PG8_MMA(0, 1, At, B1); PG8_BAR;
            PG8_LDA(At, 1, 1); PG8_STAGE(PG8_SA(1, 0), a3, voffA);
            PG8_BAR; PG8_WAIT_L(0); PG8_MMA(1, 0, At, B0); PG8_BAR; PG8_SCHED;
            PG8_STAGE(PG8_SB(1, 1), b3 + hstep, voffB);
            PG8_WAIT_V(6); PG8_BAR; PG8_MMA(1, 1, At, B1); PG8_BAR;
            }
        }
        if constexpr (ALIGN_EPI) { if (wr == 0) PG8_BAR; }
        if constexpr (FP8 != 0) asm volatile("s_nop 15\n\ts_nop 15" ::: "memory");
        if constexpr (!Epi::AFTER_DRAIN) { E(acc, cur, wr, wc, fr, fq); S.done(cur); }
        if (!has_next) break;
#pragma unroll
        for (int a = 0; a < 2; ++a)
#pragma unroll
            for (int b = 0; b < 2; ++b)
#pragma unroll
                for (int m = 0; m < 4; ++m)
#pragma unroll
                    for (int n = 0; n < 2; ++n) acc[a][b][m][n] = (f32x4){0.f, 0.f, 0.f, 0.f};
        cur = nxt; cA = nA; cB = nB; ++ui;
        if constexpr (ALIGN_EPI) { if (wr == 1) PG8_BAR; }
    }
    PG8_WAIT_V(0);
    if constexpr (!ALIGN_EPI) { if (wr == 0) PG8_BAR; }
    PG8_BAR;
    if constexpr (Epi::AFTER_DRAIN) { E.fused(acc, cur, wr, wc, fr, fq, lds, wid, lane); S.done(cur); }
#undef PG8_SA
#undef PG8_SB
#undef PG8_STAGE
#undef PG8_LDA
#undef PG8_LDB
#undef PG8_MMA
#undef PG8_WAIT_V
#undef PG8_WAIT_V8F
#undef PG8_WAIT_L
#undef PG8_BAR
#undef PG8_SCHED
}
}

constexpr int NB = 8, SEQ = 2048, DM = 4096, MT = NB * SEQ;
constexpr int LDP = 26624;
constexpr int LDPS = 18432, S_RG = 6144, S_GA = 10240, S_GR = 14336;
constexpr int C_DAQ = 0, C_DAK = 2048, C_DAV = 4096, C_RQ = 6144, C_RK = 8192, C_RV = 10240, C_RG = 14336, C_GA = 18432, C_GR = 22528;
constexpr int NE = 16384;
constexpr float LN_EPS = 1e-5f;
constexpr float DN_ALPHA = 1.189207115002721f;
constexpr float LOG2E = 1.4426950408889634f;
#ifndef LDZ_PAD
#define LDZ_PAD 64
#endif
constexpr int LDZ = DM + LDZ_PAD;

namespace pg8 {
__device__ __forceinline__ void ld8bf(const bf16_t* p, float (&f)[8]) {
    const u32x4 w = *(const u32x4*)p;
    f[0] = __uint_as_float(w.x << 16); f[1] = __uint_as_float(w.x & 0xffff0000u); f[2] = __uint_as_float(w.y << 16); f[3] = __uint_as_float(w.y & 0xffff0000u);
    f[4] = __uint_as_float(w.z << 16); f[5] = __uint_as_float(w.z & 0xffff0000u); f[6] = __uint_as_float(w.w << 16); f[7] = __uint_as_float(w.w & 0xffff0000u);
}
__device__ __forceinline__ void st8bf(bf16_t* p, const float (&f)[8]) {
    u32x4 w; w.x = cvt_pk_bf16(f[0], f[1]); w.y = cvt_pk_bf16(f[2], f[3]); w.z = cvt_pk_bf16(f[4], f[5]); w.w = cvt_pk_bf16(f[6], f[7]);
    *(u32x4*)p = w;
}
__device__ __forceinline__ float sigmoidf_(float x) { return __builtin_amdgcn_rcpf(1.0f + __builtin_amdgcn_exp2f(-x * LOG2E)); }

__device__ __forceinline__ float clamp448(float x) { return fminf(fmaxf(x, -448.0f), 448.0f); }
__device__ __forceinline__ unsigned pk4_fp8(float a, float b, float c, float d) { int w = 0; w = __builtin_amdgcn_cvt_pk_fp8_f32(clamp448(a), clamp448(b), w, false); w = __builtin_amdgcn_cvt_pk_fp8_f32(clamp448(c), clamp448(d), w, true); return (unsigned)w; }
typedef unsigned u32x2 __attribute__((ext_vector_type(2)));
__device__ __forceinline__ void unpack8(const u32x4 w, float (&f)[8]) {
    f[0] = __uint_as_float(w.x << 16); f[1] = __uint_as_float(w.x & 0xffff0000u); f[2] = __uint_as_float(w.y << 16); f[3] = __uint_as_float(w.y & 0xffff0000u);
    f[4] = __uint_as_float(w.z << 16); f[5] = __uint_as_float(w.z & 0xffff0000u); f[6] = __uint_as_float(w.w << 16); f[7] = __uint_as_float(w.w & 0xffff0000u);
}
template <class Op> struct Epi8 {
    static constexpr bool PERM = true, AFTER_DRAIN = false; static constexpr int NVM = Op::NVM;
    Op op;
    template <int ST> __device__ __forceinline__ void stage(f32x4 (&acc)[2][2][4][2], int row0, int col0, unsigned& keep) const {
        if constexpr (sizeof(typename Op::Pre) <= 16) {
            typename Op::Pre pre[2][4][2];
#pragma unroll
            for (int ai = 0; ai < 2; ++ai)
#pragma unroll
                for (int m = 0; m < 4; ++m)
#pragma unroll
                    for (int bj = 0; bj < 2; ++bj) pre[ai][m][bj] = op.template pre<ST>(row0 + ai * HALF + m * 16, col0 + bj * HALF);
#pragma unroll
            for (int ai = 0; ai < 2; ++ai)
#pragma unroll
                for (int m = 0; m < 4; ++m)
#pragma unroll
                    for (int bj = 0; bj < 2; ++bj) {
                        f32x4& a = acc[ai][bj][m][0]; f32x4& b = acc[ai][bj][m][1];
                        float v[8] = {a[0], a[1], a[2], a[3], b[0], b[1], b[2], b[3]};
                        if (!op.template apply<ST>(v, pre[ai][m][bj])) keep &= ~(1u << (ai * 8 + m * 2 + bj));
                        a = (f32x4){v[0], v[1], v[2], v[3]}; b = (f32x4){v[4], v[5], v[6], v[7]};
                    }
        } else {
#pragma unroll
        for (int ai = 0; ai < 2; ++ai) {
            typename Op::Pre pre[4][2];
#pragma unroll
            for (int m = 0; m < 4; ++m)
#pragma unroll
                for (int bj = 0; bj < 2; ++bj) pre[m][bj] = op.template pre<ST>(row0 + ai * HALF + m * 16, col0 + bj * HALF);
#pragma unroll
            for (int m = 0; m < 4; ++m)
#pragma unroll
                for (int bj = 0; bj < 2; ++bj) {
                    f32x4& a = acc[ai][bj][m][0]; f32x4& b = acc[ai][bj][m][1];
                    float v[8] = {a[0], a[1], a[2], a[3], b[0], b[1], b[2], b[3]};
                    if (!op.template apply<ST>(v, pre[m][bj])) keep &= ~(1u << (ai * 8 + m * 2 + bj));
                    a = (f32x4){v[0], v[1], v[2], v[3]}; b = (f32x4){v[4], v[5], v[6], v[7]};
                }
            __builtin_amdgcn_sched_barrier(0);
        }
        }
    }
    __device__ __forceinline__ void operator()(f32x4 (&acc)[2][2][4][2], const Unit& u, int wr, int wc, int fr, int fq) const {
        const int row0 = u.pm * BM + wr * 64 + fr, col0 = u.pn * BM + wc * 32 + 8 * fq;
        unsigned keep = 0xffffu;
        if constexpr (Op::NST >= 1) stage<0>(acc, row0, col0, keep);
        if constexpr (Op::NST >= 2) stage<1>(acc, row0, col0, keep);
#pragma unroll
        for (int ai = 0; ai < 2; ++ai)
#pragma unroll
            for (int m = 0; m < 4; ++m)
#pragma unroll
                for (int bj = 0; bj < 2; ++bj) if (keep & (1u << (ai * 8 + m * 2 + bj))) {
                    const f32x4 a = acc[ai][bj][m][0], b = acc[ai][bj][m][1];
                    const float v[8] = {a[0], a[1], a[2], a[3], b[0], b[1], b[2], b[3]};
                    op.store(row0 + ai * HALF + m * 16, col0 + bj * HALF, v);
                }
    }
};
struct NoPre {};
struct OpStore { bf16_t* O; int ld; static constexpr int NVM = 16, NST = 0; typedef NoPre Pre;
    template <int ST> __device__ __forceinline__ Pre pre(int, int) const { return Pre{}; }
    template <int ST> __device__ __forceinline__ bool apply(float (&)[8], const Pre&) const { return true; }
    __device__ __forceinline__ void store(int row, int col, const float (&v)[8]) const { st8bf(O + (size_t)row * ld + col, v); } };
typedef float f32x16 __attribute__((ext_vector_type(16)));
typedef int v6i32e __attribute__((ext_vector_type(6)));
__device__ __forceinline__ void cvt_block_fp6(const float (&x)[32], u32x4& lo, u32x4& hi) {
    f32x16 a, b;
#pragma unroll
    for (int i = 0; i < 16; ++i) { a[i] = x[i]; b[i] = x[16 + i]; }
    const v6i32e r = __builtin_amdgcn_cvt_scalef32_2xpk16_fp6_f32(a, b, 1.0f);
    lo = (u32x4){(unsigned)r[0], (unsigned)r[1], (unsigned)r[2], (unsigned)r[3]}; hi = (u32x4){(unsigned)r[4], (unsigned)r[5], 0u, 0u};
}
struct OpStoreProj { bf16_t* O; bf16_t* O2; float s; static constexpr int NVM = 16, NST = 0; typedef NoPre Pre;
    template <int ST> __device__ __forceinline__ Pre pre(int, int) const { return Pre{}; }
    template <int ST> __device__ __forceinline__ bool apply(float (&)[8], const Pre&) const { return true; }
    __device__ __forceinline__ void store(int row, int col, const float (&v)[8]) const {
        const float f = s * ((col < C_DAK) ? (0.125f * LOG2E) : ((col >= C_RK && col < C_RV) ? 0.08838834764831845f : 1.0f));
        float w[8];
#pragma unroll
        for (int i = 0; i < 8; ++i) w[i] = v[i] * f;
        const unsigned seg = (((unsigned)(col - C_RQ) >> 7) << 14) + (unsigned)row;
        bf16_t* p = (col >= C_RQ && col < C_RG) ? O2 + ((size_t)seg * 128u + ((unsigned)col & 127u)) : O + ((size_t)row * LDPS + (col >= C_RG ? col - 8192 : col));
        st8bf(p, w); } };
struct OpNull { bf16_t* O; static constexpr int NVM = 0, NST = 0; typedef NoPre Pre;
    template <int ST> __device__ __forceinline__ Pre pre(int, int) const { return Pre{}; }
    template <int ST> __device__ __forceinline__ bool apply(float (&)[8], const Pre&) const { return true; }
    __device__ __forceinline__ void store(int row, int col, const float (&v)[8]) const { if (v[0] != v[0] && v[5] != v[5]) st8bf(O + (size_t)row * 8 + col, v); } };
struct OpStoreS { bf16_t* O; int ld; float s; static constexpr int NVM = 16, NST = 0; typedef NoPre Pre;
    template <int ST> __device__ __forceinline__ Pre pre(int, int) const { return Pre{}; }
    template <int ST> __device__ __forceinline__ bool apply(float (&)[8], const Pre&) const { return true; }
    __device__ __forceinline__ void store(int row, int col, const float (&v)[8]) const {
        float w[8];
#pragma unroll
        for (int i = 0; i < 8; ++i) w[i] = v[i] * s;
        st8bf(O + (size_t)row * ld + col, w); } };
struct OpGateA { const bf16_t* P; bf16_t* O; float s; static constexpr int NVM = 32, NST = 1; typedef u32x4 Pre;
    template <int ST> __device__ __forceinline__ Pre pre(int row, int col) const { return *(const u32x4*)(P + (size_t)row * LDPS + S_GA + col); }
    template <int ST> __device__ __forceinline__ bool apply(float (&v)[8], const Pre& pr) const {
        float g[8]; unpack8(pr, g);
#pragma unroll
        for (int i = 0; i < 8; ++i) v[i] *= s * sigmoidf_(g[i]);
        return true; }
    __device__ __forceinline__ void store(int row, int col, const float (&v)[8]) const { st8bf(O + (size_t)row * DM + col, v); } };
struct PreGO { u32x4 g, o; };
struct OpGateR { const bf16_t* P; const bf16_t* Oin; unsigned char* O8; float s, so; static constexpr int NVM = 48, NST = 1; typedef PreGO Pre;
    template <int ST> __device__ __forceinline__ Pre pre(int row, int col) const { Pre p; p.g = *(const u32x4*)(P + (size_t)row * LDPS + S_GR + col); p.o = *(const u32x4*)(Oin + (size_t)row * DM + col); return p; }
    template <int ST> __device__ __forceinline__ bool apply(float (&v)[8], const Pre& pr) const {
        float g[8], o[8]; unpack8(pr.g, g); unpack8(pr.o, o);
#pragma unroll
        for (int i = 0; i < 8; ++i) v[i] = (o[i] + v[i] * s * sigmoidf_(g[i])) * so;
        return true; }
    __device__ __forceinline__ void store(int row, int col, const float (&v)[8]) const {
        u32x2 w; w.x = pk4_fp8(v[0], v[1], v[2], v[3]); w.y = pk4_fp8(v[4], v[5], v[6], v[7]);
        *(u32x2*)(O8 + (size_t)row * DM + col) = w; } };
struct PreX { f32x4 x0, x1; };
struct OpResF32 { const float* X; bf16_t* O; float s; static constexpr int NVM = 48, NST = 1; typedef PreX Pre;
    template <int ST> __device__ __forceinline__ Pre pre(int row, int col) const { Pre p; p.x0 = *(const f32x4*)(X + (size_t)row * DM + col); p.x1 = *(const f32x4*)(X + (size_t)row * DM + col + 4); return p; }
    template <int ST> __device__ __forceinline__ bool apply(float (&v)[8], const Pre& pr) const {
        v[0] = v[0] * s + DN_ALPHA * pr.x0[0]; v[1] = v[1] * s + DN_ALPHA * pr.x0[1]; v[2] = v[2] * s + DN_ALPHA * pr.x0[2]; v[3] = v[3] * s + DN_ALPHA * pr.x0[3];
        v[4] = v[4] * s + DN_ALPHA * pr.x1[0]; v[5] = v[5] * s + DN_ALPHA * pr.x1[1]; v[6] = v[6] * s + DN_ALPHA * pr.x1[2]; v[7] = v[7] * s + DN_ALPHA * pr.x1[3];
        return true; }
    __device__ __forceinline__ void store(int row, int col, const float (&v)[8]) const { st8bf(O + (size_t)row * LDZ + col, v); } };
struct OpResF32NoStore { const float* X; bf16_t* O; float s; static constexpr int NVM = 0, NST = 1; typedef PreX Pre;
    template <int ST> __device__ __forceinline__ Pre pre(int row, int col) const { Pre p; p.x0 = *(const f32x4*)(X + (size_t)row * DM + col); p.x1 = *(const f32x4*)(X + (size_t)row * DM + col + 4); return p; }
    template <int ST> __device__ __forceinline__ bool apply(float (&v)[8], const Pre& pr) const { v[0] += pr.x0[0]; v[1] += pr.x0[1]; v[2] += pr.x0[2]; v[3] += pr.x0[3]; v[4] += pr.x1[0]; v[5] += pr.x1[1]; v[6] += pr.x1[2]; v[7] += pr.x1[3]; return true; }
    __device__ __forceinline__ void store(int row, int col, const float (&v)[8]) const { if (v[0] != v[0] && v[5] != v[5]) st8bf(O + (size_t)row * DM + col, v); } };
struct OpResF32NoLoad { const float* X; bf16_t* O; float s; static constexpr int NVM = 0, NST = 0; typedef NoPre Pre;
    template <int ST> __device__ __forceinline__ Pre pre(int, int) const { return Pre{}; }
    template <int ST> __device__ __forceinline__ bool apply(float (&)[8], const Pre&) const { return true; }
    __device__ __forceinline__ void store(int row, int col, const float (&v)[8]) const { st8bf(O + (size_t)row * DM + col, v); } };
struct OpPeerH8 { unsigned char* GA; float hs; static constexpr int NVM = 16, NST = 1; typedef u32x2 Pre;
    template <int ST> __device__ __forceinline__ Pre pre(int row, int col) const { return *(const u32x2*)(GA + (size_t)row * NE + col); }
    template <int ST> __device__ __forceinline__ bool apply(float (&v)[8], const Pre& w) const {
        if ((w.x | w.y) == 0u) return false;
        float g[8];
        g[0] = __builtin_amdgcn_cvt_f32_fp8((int)w.x, 0); g[1] = __builtin_amdgcn_cvt_f32_fp8((int)w.x, 1); g[2] = __builtin_amdgcn_cvt_f32_fp8((int)w.x, 2); g[3] = __builtin_amdgcn_cvt_f32_fp8((int)w.x, 3);
        g[4] = __builtin_amdgcn_cvt_f32_fp8((int)w.y, 0); g[5] = __builtin_amdgcn_cvt_f32_fp8((int)w.y, 1); g[6] = __builtin_amdgcn_cvt_f32_fp8((int)w.y, 2); g[7] = __builtin_amdgcn_cvt_f32_fp8((int)w.y, 3);
#pragma unroll
        for (int i = 0; i < 8; i += 2) { const f32x2 r = gelu_pk((f32x2){v[i] * hs, v[i + 1] * hs}); v[i] = r.x * g[i]; v[i + 1] = r.y * g[i + 1]; }
        return true; }
    __device__ __forceinline__ void store(int row, int col, const float (&v)[8]) const {
        u32x2 o; o.x = pk4_fp8(v[0], v[1], v[2], v[3]); o.y = pk4_fp8(v[4], v[5], v[6], v[7]);
        *(u32x2*)(GA + (size_t)row * NE + col) = o; } };
template <bool NOGELU> struct OpPeerH8Probe { const unsigned char* GA; unsigned char* GO; float hs; static constexpr int NVM = 0, NST = 1; typedef u32x2 Pre;
    template <int ST> __device__ __forceinline__ Pre pre(int row, int col) const { return *(const u32x2*)(GA + (size_t)row * NE + col); }
    template <int ST> __device__ __forceinline__ bool apply(float (&v)[8], const Pre& w) const {
        if ((w.x | w.y) == 0u) return false;
        float g[8];
        g[0] = __builtin_amdgcn_cvt_f32_fp8((int)w.x, 0); g[1] = __builtin_amdgcn_cvt_f32_fp8((int)w.x, 1); g[2] = __builtin_amdgcn_cvt_f32_fp8((int)w.x, 2); g[3] = __builtin_amdgcn_cvt_f32_fp8((int)w.x, 3);
        g[4] = __builtin_amdgcn_cvt_f32_fp8((int)w.y, 0); g[5] = __builtin_amdgcn_cvt_f32_fp8((int)w.y, 1); g[6] = __builtin_amdgcn_cvt_f32_fp8((int)w.y, 2); g[7] = __builtin_amdgcn_cvt_f32_fp8((int)w.y, 3);
#pragma unroll
        for (int i = 0; i < 8; i += 2) { if (NOGELU) { v[i] = v[i] * hs * g[i]; v[i + 1] = v[i + 1] * hs * g[i + 1]; } else { const f32x2 r = gelu_pk((f32x2){v[i] * hs, v[i + 1] * hs}); v[i] = r.x * g[i]; v[i + 1] = r.y * g[i + 1]; } }
        return true; }
    __device__ __forceinline__ void store(int row, int col, const float (&v)[8]) const {
        u32x2 o; o.x = pk4_fp8(v[0], v[1], v[2], v[3]); o.y = pk4_fp8(v[4], v[5], v[6], v[7]);
        *(u32x2*)(GO + (size_t)row * NE + col) = o; } };
struct OpResBfS { const bf16_t* X; bf16_t* O; float s; static constexpr int NVM = 32, NST = 1; typedef u32x4 Pre;
    template <int ST> __device__ __forceinline__ Pre pre(int row, int col) const { return *(const u32x4*)(X + (size_t)row * DM + col); }
    template <int ST> __device__ __forceinline__ bool apply(float (&v)[8], const Pre& pr) const {
        float x[8]; unpack8(pr, x);
#pragma unroll
        for (int i = 0; i < 8; ++i) v[i] = v[i] * s + DN_ALPHA * x[i];
        return true; }
    __device__ __forceinline__ void store(int row, int col, const float (&v)[8]) const { st8bf(O + (size_t)row * LDZ + col, v); } };
}

namespace mix {
typedef unsigned short bf16_t;
typedef short bf16x8 __attribute__((ext_vector_type(8)));
typedef short s16x4 __attribute__((ext_vector_type(4)));
typedef float f32x16 __attribute__((ext_vector_type(16)));
typedef unsigned u32x4 __attribute__((ext_vector_type(4)));
typedef float f32x4v __attribute__((ext_vector_type(4)));
#define MIX_LAS __attribute__((address_space(3)))
#ifndef MIX_PP
#define MIX_PP false
#endif
#ifndef MIX_PF
#define MIX_PF true
#endif
constexpr int KCS = 1040;
__device__ __forceinline__ constexpr int crow(int r, int hi) { return (r & 3) + 8 * (r >> 2) + 4 * hi; }
__device__ __forceinline__ unsigned voff_b(unsigned row, unsigned ch) { return 256u * row + 16u * (ch ^ (((row & 3u) << 2) | ((row >> 2) & 3u))); }
typedef float f32x2_t __attribute__((ext_vector_type(2))); typedef __bf16 bf16x2_t __attribute__((ext_vector_type(2)));
__device__ __forceinline__ unsigned pk_bf16(float lo, float hi) { const f32x2_t v = {lo, hi}; return __builtin_bit_cast(unsigned, __builtin_convertvector(v, bf16x2_t)); }
__device__ __forceinline__ float swapmax(float v) { auto rr = __builtin_amdgcn_permlane32_swap(__float_as_uint(v), __float_as_uint(v), false, false); return fmaxf(__uint_as_float(rr[0]), __uint_as_float(rr[1])); }
__device__ __forceinline__ float swapadd(float v) { auto rr = __builtin_amdgcn_permlane32_swap(__float_as_uint(v), __float_as_uint(v), false, false); return __uint_as_float(rr[0]) + __uint_as_float(rr[1]); }
template <int CTRL> __device__ __forceinline__ float dpp_add(float v) { return v + __uint_as_float(__builtin_amdgcn_update_dpp(0u, __float_as_uint(v), CTRL, 0xf, 0xf, true)); }
__device__ __forceinline__ float sum32(float v) {
    v = dpp_add<0xB1>(v); v = dpp_add<0x4E>(v);
    v = dpp_add<0x141>(v); v = dpp_add<0x140>(v);
    auto rr = __builtin_amdgcn_permlane16_swap(__float_as_uint(v), __float_as_uint(v), false, false);
    return __uint_as_float(rr[0]) + __uint_as_float(rr[1]);
}
template <int D, int NVIMG> struct Lay { static constexpr int KB = (D / 8) * KCS, VB = NVIMG * 16384, BUF = KB + VB; };

template <int D, bool SOFT>
__device__ __forceinline__ void tl_scores(const MIX_LAS unsigned char* kb, unsigned kaddr, const bf16x8 (&qf)[D / 16], int t, int qpos0, int qpos, int hi, int r32, float par,
                                          MIX_LAS float* wsf, f32x16 (&o)[4], float& m_run, float& l_run, u32x4 (&pw)[4]) {
    f32x16 p0, p1;
    const int kbase = 64 * t + 4 * hi;
    if (SOFT) {
        const float b0 = par * (float)(kbase - qpos);
#pragma unroll
        for (int r = 0; r < 16; ++r) { p0[r] = fmaf(par, (float)((r & 3) + 8 * (r >> 2)), b0); p1[r] = p0[r] + 32.0f * par; }
    } else {
#pragma unroll
        for (int r = 0; r < 16; ++r) { p0[r] = 0.f; p1[r] = 0.f; }
    }
#pragma unroll
    for (int d0 = 0; d0 < D / 16; ++d0) {
        const bf16x8 a0 = *(const MIX_LAS bf16x8*)(kb + kaddr + d0 * 2 * KCS);
        const bf16x8 a1 = *(const MIX_LAS bf16x8*)(kb + kaddr + d0 * 2 * KCS + 512);
        p0 = __builtin_amdgcn_mfma_f32_32x32x16_bf16(a0, qf[d0], p0, 0, 0, 0);
        p1 = __builtin_amdgcn_mfma_f32_32x32x16_bf16(a1, qf[d0], p1, 0, 0, 0);
        if (D > 64 && (d0 & 1)) __builtin_amdgcn_sched_barrier(0);
    }
    const bool needmask = (64 * t + 63 > qpos0);
    if (SOFT) {
        if (needmask) {
#pragma unroll
            for (int r = 0; r < 16; ++r) { const int kp = kbase + (r & 3) + 8 * (r >> 2); if (kp > qpos) p0[r] = -INFINITY; if (kp + 32 > qpos) p1[r] = -INFINITY; }
        }
        float mt = fmaxf(p0[0], p1[0]);
#pragma unroll
        for (int r = 1; r < 16; ++r) mt = fmaxf(mt, fmaxf(p0[r], p1[r]));
        mt = swapmax(mt);
        const float m_new = fmaxf(m_run, mt);
        if (__any(m_new > m_run)) {
            const float alpha = __builtin_amdgcn_exp2f(m_run - m_new);
            if (hi == 0) wsf[r32] = alpha;
            asm volatile("s_waitcnt lgkmcnt(0)" ::: "memory");
            l_run *= alpha; m_run = m_new;
#pragma unroll
            for (int r = 0; r < 16; ++r) { const float a = wsf[crow(r, hi)];
#pragma unroll
                for (int c = 0; c < 4; ++c) o[c][r] *= a; }
            asm volatile("s_waitcnt lgkmcnt(0)" ::: "memory");
        }
        float sacc = 0.f;
#pragma unroll
        for (int r = 0; r < 16; ++r) { p0[r] = __builtin_amdgcn_exp2f(p0[r] - m_run); p1[r] = __builtin_amdgcn_exp2f(p1[r] - m_run); sacc += p0[r] + p1[r]; }
        l_run += sacc;
    } else {
        const float rf0 = __builtin_amdgcn_exp2f(par * (float)(qpos - kbase)), rf1 = rf0 * __builtin_amdgcn_exp2f(-32.0f * par);
        float rb0[4], rb1[4];
#pragma unroll
        for (int i = 0; i < 4; ++i) { const float bq = __builtin_amdgcn_exp2f(-8.0f * par * (float)i); rb0[i] = rf0 * bq; rb1[i] = rf1 * bq; }
#pragma unroll
        for (int r = 0; r < 16; ++r) { const float ca = __builtin_amdgcn_exp2f(-par * (float)(r & 3)); p0[r] *= rb0[r >> 2] * ca; p1[r] *= rb1[r >> 2] * ca; }
        if (needmask) {
#pragma unroll
            for (int r = 0; r < 16; ++r) { const int kp = kbase + (r & 3) + 8 * (r >> 2); if (kp > qpos) p0[r] = 0.f; if (kp + 32 > qpos) p1[r] = 0.f; }
        }
    }
#pragma unroll
    for (int j = 0; j < 4; ++j) { pw[0][j] = pk_bf16(p0[2 * j], p0[2 * j + 1]); pw[1][j] = pk_bf16(p0[8 + 2 * j], p0[9 + 2 * j]);
                                  pw[2][j] = pk_bf16(p1[2 * j], p1[2 * j + 1]); pw[3][j] = pk_bf16(p1[8 + 2 * j], p1[9 + 2 * j]); }
}
__device__ __forceinline__ void tl_pv(const MIX_LAS unsigned char* vb, const unsigned (&vaddr)[4][2], const u32x4 (&pw)[4], f32x16 (&o)[4]) {
#pragma unroll
    for (int c = 0; c < 4; ++c) {
        s16x4 lo[4], hh[4];
#pragma unroll
        for (int ks = 0; ks < 4; ++ks) {
            lo[ks] = __builtin_amdgcn_ds_read_tr16_b64_v4i16((MIX_LAS s16x4*)(vb + vaddr[c][0] + 4096 * ks));
            hh[ks] = __builtin_amdgcn_ds_read_tr16_b64_v4i16((MIX_LAS s16x4*)(vb + vaddr[c][1] + 4096 * ks));
        }
#pragma unroll
        for (int ks = 0; ks < 4; ++ks) {
            const bf16x8 vf = (bf16x8){lo[ks][0], lo[ks][1], lo[ks][2], lo[ks][3], hh[ks][0], hh[ks][1], hh[ks][2], hh[ks][3]};
            o[c] = __builtin_amdgcn_mfma_f32_32x32x16_bf16(__builtin_bit_cast(bf16x8, pw[ks]), vf, o[c], 0, 0, 0);
        }
        __builtin_amdgcn_sched_barrier(0);
    }
}

template <int D, int NVIMG, bool SOFT, bool PP, bool PF = false, int VAR = 0>
__device__ __forceinline__ void tile_loop(MIX_LAS unsigned char* lds, MIX_LAS float* wsf, const bf16_t* Qg, const bf16_t* Kg, const bf16_t* Vg,
                                          int qpos0, int vimg, int t0, int nt, float par, f32x16 (&o)[4], float& m_run, float& l_run) {
    typedef Lay<D, NVIMG> L;
    int tid = threadIdx.x; asm volatile("" : "+v"(tid));
    const int lane = tid & 63, r32 = lane & 31, hi = lane >> 5;
    constexpr int NKL = D / 64, NVL = 2 * NVIMG, CPK = D / 8;
    bf16x8 qf[D / 16];
#pragma unroll
    for (int d0 = 0; d0 < D / 16; ++d0) qf[d0] = *(const bf16x8*)(Qg + (size_t)(qpos0 + r32) * LDPS + d0 * 16 + hi * 8);
    const int qpos = qpos0 + r32;
    unsigned kgo[NKL], klo[NKL], vgo[NVL], vlo[NVL];
#pragma unroll
    for (int i = 0; i < NKL; ++i) { const int idx = tid + 512 * i, ch = idx % CPK, key = idx / CPK; kgo[i] = (unsigned)(key * LDPS + ch * 8) * 2u; klo[i] = (unsigned)(ch * KCS + key * 16); }
#pragma unroll
    for (int i = 0; i < NVL; ++i) { const int idx = tid + 512 * i, im = idx >> 10, key = (idx & 1023) >> 4, ch = idx & 15; vgo[i] = (unsigned)(key * LDPS + im * 128 + ch * 8) * 2u; vlo[i] = (unsigned)(L::KB + im * 16384) + voff_b(key, ch); }
    u32x4 kst[NKL], vst[NVL];
    constexpr size_t TSTEP = (size_t)64 * LDPS * 2;
#define MIX_LOADK(t_) do { const char* kt_ = (const char*)Kg + (size_t)(t_) * TSTEP; _Pragma("unroll") for (int i = 0; i < NKL; ++i) kst[i] = *(const u32x4*)(kt_ + kgo[i]); } while (0)
#define MIX_LOADV(t_) do { const char* vt_ = (const char*)Vg + (size_t)(t_) * TSTEP; _Pragma("unroll") for (int i = 0; i < NVL; ++i) vst[i] = *(const u32x4*)(vt_ + vgo[i]); } while (0)
#define MIX_STOREK(b_) do { MIX_LAS unsigned char* bb = lds + (b_) * L::BUF; _Pragma("unroll") for (int i = 0; i < NKL; ++i) *(MIX_LAS u32x4*)(bb + klo[i]) = kst[i]; } while (0)
#define MIX_STOREV(b_) do { MIX_LAS unsigned char* bb = lds + (b_) * L::BUF; _Pragma("unroll") for (int i = 0; i < NVL; ++i) *(MIX_LAS u32x4*)(bb + vlo[i]) = vst[i]; } while (0)
    const unsigned tq = (lane & 15) >> 2, tp = lane & 3, tblk = (lane >> 4) & 1;
    unsigned vaddr[4][2];
#pragma unroll
    for (int c = 0; c < 4; ++c)
#pragma unroll
        for (int tt = 0; tt < 2; ++tt) vaddr[c][tt] = voff_b(8u * tt + 4u * hi + tq, 4u * c + 2u * tblk + (tp >> 1)) + 8u * (tp & 1u);
    const unsigned kaddr = (unsigned)(hi * KCS + r32 * 16);
    u32x4 pw[4] = {};
    MIX_LOADK(t0); MIX_LOADV(t0); MIX_STOREK(t0 & 1); MIX_STOREV(t0 & 1); __syncthreads();
    if constexpr (PP) {
        const bool lag = (__builtin_amdgcn_readfirstlane(tid >> 6) >= 4);
        const int tend = t0 + nt;
        for (int iv = 0; iv < 2 * nt + 2; ++iv) {
            const int t = t0 + (iv >> 1); const bool odd = (iv & 1) != 0;
            const bool more = (t + 1 < tend);
            if (more) { if (!odd) { MIX_LOADK(t + 1); MIX_LOADV(t + 1); } else { MIX_STOREK((t + 1) & 1); MIX_STOREV((t + 1) & 1); } }
            const int tb = lag ? t - 1 : t;
            const bool doB = (lag != odd) && (tb >= t0) && (tb < tend) && (64 * tb <= qpos0 + 31);
            const bool doA = (lag == odd) && (t < tend) && (64 * t <= qpos0 + 31);
            if (doB) tl_pv(lds + (tb & 1) * L::BUF + L::KB + vimg * 16384, vaddr, pw, o);
            if (doA) tl_scores<D, SOFT>(lds + (t & 1) * L::BUF, kaddr, qf, t, qpos0, qpos, hi, r32, par, wsf, o, m_run, l_run, pw);
            __syncthreads();
        }
    } else if constexpr (PF) {
        const int tend = t0 + nt;
        if (nt > 1) { MIX_LOADK(t0 + 1); MIX_LOADV(t0 + 1); }
        for (int t = t0; t < tend; ++t) {
            const bool active = (64 * t <= qpos0 + 31);
            if (t + 1 < tend) { MIX_STOREK((t + 1) & 1); MIX_STOREV((t + 1) & 1); }
            if (t + 2 < tend) { MIX_LOADK(t + 2); MIX_LOADV(t + 2); }
            const MIX_LAS unsigned char* kb = lds + (t & 1) * L::BUF;
            if (active) { if (VAR < 2) tl_scores<D, SOFT>(kb, kaddr, qf, t, qpos0, qpos, hi, r32, par, wsf, o, m_run, l_run, pw); if (VAR < 1) tl_pv(kb + L::KB + vimg * 16384, vaddr, pw, o); }
            asm volatile("s_waitcnt lgkmcnt(0)\n\ts_barrier" ::: "memory");
        }
    } else {
        for (int t = t0; t < t0 + nt; ++t) {
            const bool more = (t + 1 < t0 + nt);
            const bool active = (64 * t <= qpos0 + 31);
            if (more) MIX_LOADV(t + 1);
            const MIX_LAS unsigned char* kb = lds + (t & 1) * L::BUF;
            if (active) tl_scores<D, SOFT>(kb, kaddr, qf, t, qpos0, qpos, hi, r32, par, wsf, o, m_run, l_run, pw);
            if (more) { MIX_STOREV((t + 1) & 1); MIX_LOADK(t + 1); }
            if (active) tl_pv(kb + L::KB + vimg * 16384, vaddr, pw, o);
            if (more) MIX_STOREK((t + 1) & 1);
            __syncthreads();
        }
    }
#undef MIX_LOADK
#undef MIX_LOADV
#undef MIX_STOREK
#undef MIX_STOREV
}

constexpr float ATT_SCALE = 8.0f, RET_SCALE = 8.0f;
struct MixArgs { const bf16_t* P; unsigned char* atto; unsigned char* reto; bf16_t* state;
  const float* lam_p; const float* subln_w; const float* gn_w; const float* gn_b; };
template <int VAR = 0> __device__ __forceinline__ void attn_unit(MIX_LAS unsigned char* lds, const MixArgs& A, int b, int h, int qb) {
    typedef Lay<64, 1> L;
    const int tid = threadIdx.x, lane = tid & 63, r32 = lane & 31, hi = lane >> 5, wave = __builtin_amdgcn_readfirstlane(tid >> 6);
    MIX_LAS float* wsf = (MIX_LAS float*)(lds + 2 * L::BUF) + wave * 64;
    float lam;
    { const float a = A.lam_p[lane] * A.lam_p[64 + lane], c = A.lam_p[128 + lane] * A.lam_p[192 + lane];
      float sa = a, sc = c;
#pragma unroll
      for (int o_ = 1; o_ < 64; o_ <<= 1) { sa += __shfl_xor(sa, o_); sc += __shfl_xor(sc, o_); }
      lam = __expf(sa) - __expf(sc) + 0.2f; }
    const float sl2 = exp2f(-0.5f * (float)(h + 1)) * LOG2E;
    const int qpos0 = qb * 256 + wave * 32, nt = 4 * (qb + 1);
    const bf16_t* base = A.P + (size_t)b * SEQ * LDPS;
    const bf16_t* Vg = base + C_DAV + h * 128;
    MIX_LAS unsigned* stash = (MIX_LAS unsigned*)(lds + 2 * L::BUF + 8 * 256) + wave * 2048 + lane;
    f32x16 o[4];
#pragma unroll
    for (int mp = 0; mp < 2; ++mp) {
        const bf16_t* Qg = base + C_DAQ + h * 128 + mp * 64; const bf16_t* Kg = base + C_DAK + h * 128 + mp * 64;
#pragma unroll
        for (int c = 0; c < 4; ++c)
#pragma unroll
            for (int r = 0; r < 16; ++r) o[c][r] = 0.f;
        float m_run = -INFINITY, l_run = 0.f;
        tile_loop<64, 1, true, MIX_PP, MIX_PF, VAR>(lds, wsf, Qg, Kg, Vg, qpos0, 0, 0, (VAR == 3) ? 1 : nt, sl2, o, m_run, l_run);
        const float inv = __builtin_amdgcn_rcpf(swapadd(l_run));
        if (hi == 0) wsf[r32] = inv;
        asm volatile("s_waitcnt lgkmcnt(0)" ::: "memory");
#pragma unroll
        for (int r = 0; r < 16; ++r) { const float a = wsf[crow(r, hi)];
#pragma unroll
            for (int c = 0; c < 4; ++c) o[c][r] *= a; }
        asm volatile("s_waitcnt lgkmcnt(0)" ::: "memory");
        if (mp == 0) {
#pragma unroll
            for (int c = 0; c < 4; ++c)
#pragma unroll
                for (int j = 0; j < 8; ++j) stash[64 * (c * 8 + j)] = pk_bf16(o[c][2 * j], o[c][2 * j + 1]);
        }
    }
    int r32e = r32, hie = hi; asm volatile("" : "+v"(r32e), "+v"(hie));
    float ss[16];
#pragma unroll
    for (int r = 0; r < 16; ++r) ss[r] = 0.f;
#pragma unroll
    for (int c = 0; c < 4; ++c)
#pragma unroll
        for (int j = 0; j < 8; ++j) {
            const unsigned sv = stash[64 * (c * 8 + j)]; const float a0 = __uint_as_float(sv << 16), a1 = __uint_as_float(sv & 0xffff0000u);
            o[c][2 * j] = a0 - lam * o[c][2 * j]; o[c][2 * j + 1] = a1 - lam * o[c][2 * j + 1];
            ss[2 * j] += o[c][2 * j] * o[c][2 * j]; ss[2 * j + 1] += o[c][2 * j + 1] * o[c][2 * j + 1];
        }
    float sw[4];
#pragma unroll
    for (int c = 0; c < 4; ++c) sw[c] = A.subln_w[32 * c + r32e] * (0.8f * ATT_SCALE);
    __syncthreads();
    MIX_LAS float* stg = (MIX_LAS float*)(lds + wave * 16384);
#pragma unroll
    for (int r = 0; r < 16; ++r) {
        const float rs = rsqrtf(sum32(ss[r]) * (1.0f / 128.0f) + LN_EPS);
#pragma unroll
        for (int c = 0; c < 4; ++c) stg[crow(r, hie) * 128 + 32 * c + r32e] = o[c][r] * rs * sw[c];
    }
    asm volatile("s_waitcnt lgkmcnt(0)" ::: "memory");
    unsigned char* obase = A.atto + (size_t)(b * SEQ + qpos0) * 2048 + h * 128;
#pragma unroll
    for (int i = 0; i < 8; ++i) {
        const int row = 4 * i + (lane >> 4), vg = lane & 15;
        const f32x4v x0 = *(const MIX_LAS f32x4v*)(stg + row * 128 + vg * 8), x1 = *(const MIX_LAS f32x4v*)(stg + row * 128 + vg * 8 + 4);
        pg8::u32x2 w; w.x = pg8::pk4_fp8(x0[0], x0[1], x0[2], x0[3]); w.y = pg8::pk4_fp8(x1[0], x1[1], x1[2], x1[3]);
        *(pg8::u32x2*)(obase + (size_t)row * 2048 + vg * 8) = w;
    }
    __syncthreads();
}

__device__ __forceinline__ void ret_state_unit(MIX_LAS unsigned char* lds, const MixArgs& A, int b, int h, int vs) {
    int tid = threadIdx.x; asm volatile("" : "+v"(tid));
    const int lane = tid & 63, r32 = lane & 31, hi = lane >> 5, wave = __builtin_amdgcn_readfirstlane(tid >> 6);
    const int db = wave >> 1, vh = wave & 1;
    const float lg2 = log2f(1.0f - exp2f(-5.0f - (float)h));
    const float g128 = exp2f(128.0f * lg2);
    const bf16_t* base = A.P + (size_t)b * SEQ * LDP;
    const char* Kg = (const char*)(base + C_RK + h * 128); const char* Vg = (const char*)(base + C_RV + h * 256 + vs * 128);
    unsigned go[4], lo_[4]; float kf[4];
#pragma unroll
    for (int i = 0; i < 4; ++i) { const int idx = tid + 512 * i, key = idx >> 4, ch = idx & 15; go[i] = (unsigned)(key * LDP + ch * 8) * 2u; lo_[i] = (unsigned)((key >> 6) * 16384) + voff_b(key & 63, ch); kf[i] = exp2f(lg2 * (float)(127 - key)); }
    constexpr size_t CSTEP = (size_t)128 * LDP * 2;
    u32x4 kst[4], vst[4];
#define RS_LOAD(c_) do { const char* kc_ = Kg + (size_t)(c_) * CSTEP; const char* vc_ = Vg + (size_t)(c_) * CSTEP; \
        _Pragma("unroll") for (int i = 0; i < 4; ++i) { kst[i] = *(const u32x4*)(kc_ + go[i]); vst[i] = *(const u32x4*)(vc_ + go[i]); } } while (0)
#define RS_STORE(b_) do { MIX_LAS unsigned char* bb = lds + (b_) * 65536; \
        _Pragma("unroll") for (int i = 0; i < 4; ++i) { u32x4 w; const float f = kf[i]; \
            w.x = pk_bf16(__uint_as_float(kst[i].x << 16) * f, __uint_as_float(kst[i].x & 0xffff0000u) * f); w.y = pk_bf16(__uint_as_float(kst[i].y << 16) * f, __uint_as_float(kst[i].y & 0xffff0000u) * f); \
            w.z = pk_bf16(__uint_as_float(kst[i].z << 16) * f, __uint_as_float(kst[i].z & 0xffff0000u) * f); w.w = pk_bf16(__uint_as_float(kst[i].w << 16) * f, __uint_as_float(kst[i].w & 0xffff0000u) * f); \
            *(MIX_LAS u32x4*)(bb + lo_[i]) = w; *(MIX_LAS u32x4*)(bb + 32768 + lo_[i]) = vst[i]; } } while (0)
    const unsigned tq = (lane & 15) >> 2, tp = lane & 3, tblk = (lane >> 4) & 1;
    unsigned ka[2], va[2][2];
#pragma unroll
    for (int tt = 0; tt < 2; ++tt) { ka[tt] = voff_b(8u * hi + 4u * tt + tq, 4u * db + 2u * tblk + (tp >> 1)) + 8u * (tp & 1u);
#pragma unroll
        for (int cc = 0; cc < 2; ++cc) va[cc][tt] = voff_b(8u * hi + 4u * tt + tq, 4u * (2 * vh + cc) + 2u * tblk + (tp >> 1)) + 8u * (tp & 1u); }
    f32x16 acc[2];
#pragma unroll
    for (int cc = 0; cc < 2; ++cc)
#pragma unroll
        for (int r = 0; r < 16; ++r) acc[cc][r] = 0.f;
    RS_LOAD(0); RS_STORE(0); __syncthreads();
    for (int c = 0; c < 15; ++c) {
        if (c + 1 < 15) RS_LOAD(c + 1);
        const MIX_LAS unsigned char* kb = lds + (c & 1) * 65536;
#pragma unroll
        for (int cc = 0; cc < 2; ++cc)
#pragma unroll
            for (int r = 0; r < 16; ++r) acc[cc][r] *= g128;
#pragma unroll
        for (int ks = 0; ks < 8; ++ks) {
            const MIX_LAS unsigned char* ki = kb + (ks >> 2) * 16384 + (ks & 3) * 4096; const MIX_LAS unsigned char* vi = ki + 32768;
            const s16x4 a0 = __builtin_amdgcn_ds_read_tr16_b64_v4i16((MIX_LAS s16x4*)(ki + ka[0])), a1 = __builtin_amdgcn_ds_read_tr16_b64_v4i16((MIX_LAS s16x4*)(ki + ka[1]));
            const bf16x8 af = (bf16x8){a0[0], a0[1], a0[2], a0[3], a1[0], a1[1], a1[2], a1[3]};
#pragma unroll
            for (int cc = 0; cc < 2; ++cc) {
                const s16x4 b0 = __builtin_amdgcn_ds_read_tr16_b64_v4i16((MIX_LAS s16x4*)(vi + va[cc][0])), b1 = __builtin_amdgcn_ds_read_tr16_b64_v4i16((MIX_LAS s16x4*)(vi + va[cc][1]));
                const bf16x8 bfr = (bf16x8){b0[0], b0[1], b0[2], b0[3], b1[0], b1[1], b1[2], b1[3]};
                acc[cc] = __builtin_amdgcn_mfma_f32_32x32x16_bf16(af, bfr, acc[cc], 0, 0, 0);
            }
        }
        bf16_t* so = A.state + ((size_t)((b * 16 + h) * 16 + c + 1) * 128 + 32 * db) * 256 + 128 * vs + 64 * vh + r32;
#pragma unroll
        for (int cc = 0; cc < 2; ++cc)
#pragma unroll
            for (int r = 0; r < 16; ++r) so[(size_t)crow(r, hi) * 256 + 32 * cc] = (bf16_t)(pk_bf16(acc[cc][r], 0.f) & 0xffffu);
        if (c + 1 < 15) RS_STORE((c + 1) & 1);
        asm volatile("s_waitcnt lgkmcnt(0)\n\ts_barrier" ::: "memory");
    }
    __syncthreads();
#undef RS_LOAD
#undef RS_STORE
}

__device__ __forceinline__ void ret_unit(MIX_LAS unsigned char* lds, const MixArgs& A, int b, int h, int qb) {
    typedef Lay<128, 2> L;
    int tid = threadIdx.x; asm volatile("" : "+v"(tid));
    const int lane = tid & 63, r32 = lane & 31, hi = lane >> 5, wave = __builtin_amdgcn_readfirstlane(tid >> 6);
    const int rg = wave >> 1, vh = wave & 1;
    MIX_LAS float* wsf = (MIX_LAS float*)(lds + 2 * L::BUF) + wave * 64;
    MIX_LAS float* stats = (MIX_LAS float*)(lds + 132096);
    const float lg2 = log2f(1.0f - exp2f(-5.0f - (float)h));
    const int qpos0 = qb * 128 + rg * 32;
    const bf16_t* base = A.P + (size_t)b * SEQ * LDP;
    f32x16 o[4];
#pragma unroll
    for (int c = 0; c < 4; ++c)
#pragma unroll
        for (int r = 0; r < 16; ++r) o[c][r] = 0.f;
    if (qb > 0) {
        const char* Sg = (const char*)(A.state + (size_t)((b * 16 + h) * 16 + qb) * 128 * 256);
        u32x4 st[8];
#pragma unroll
        for (int i = 0; i < 8; ++i) { const int idx = tid + 512 * i, t = idx >> 11, im = (idx >> 10) & 1, row = (idx & 1023) >> 4, ch = idx & 15;
            st[i] = *(const u32x4*)(Sg + ((size_t)(t * 64 + row) * 256 + im * 128 + ch * 8) * 2); }
#pragma unroll
        for (int i = 0; i < 8; ++i) { const int idx = tid + 512 * i, t = idx >> 11, im = (idx >> 10) & 1, row = (idx & 1023) >> 4, ch = idx & 15;
            *(MIX_LAS u32x4*)(lds + t * L::BUF + L::KB + im * 16384 + voff_b(row, ch)) = st[i]; }
        bf16x8 qa[8];
#pragma unroll
        for (int d0 = 0; d0 < 8; ++d0) qa[d0] = *(const bf16x8*)(base + (size_t)(qpos0 + r32) * LDP + C_RQ + h * 128 + d0 * 16 + hi * 8);
        __syncthreads();
        const unsigned tq = (lane & 15) >> 2, tp = lane & 3, tblk = (lane >> 4) & 1;
        unsigned vn[4][2];
#pragma unroll
        for (int c = 0; c < 4; ++c)
#pragma unroll
            for (int tt = 0; tt < 2; ++tt) vn[c][tt] = voff_b(8u * hi + 4u * tt + tq, 4u * c + 2u * tblk + (tp >> 1)) + 8u * (tp & 1u);
#pragma unroll
        for (int t = 0; t < 2; ++t) {
            const MIX_LAS unsigned char* vb = lds + t * L::BUF + L::KB + vh * 16384;
#pragma unroll
            for (int c = 0; c < 4; ++c) {
                s16x4 lo[4], hh[4];
#pragma unroll
                for (int ks = 0; ks < 4; ++ks) {
                    lo[ks] = __builtin_amdgcn_ds_read_tr16_b64_v4i16((MIX_LAS s16x4*)(vb + vn[c][0] + 4096 * ks));
                    hh[ks] = __builtin_amdgcn_ds_read_tr16_b64_v4i16((MIX_LAS s16x4*)(vb + vn[c][1] + 4096 * ks));
                }
#pragma unroll
                for (int ks = 0; ks < 4; ++ks) {
                    const bf16x8 vf = (bf16x8){lo[ks][0], lo[ks][1], lo[ks][2], lo[ks][3], hh[ks][0], hh[ks][1], hh[ks][2], hh[ks][3]};
                    o[c] = __builtin_amdgcn_mfma_f32_32x32x16_bf16(qa[4 * t + ks], vf, o[c], 0, 0, 0);
                }
                __builtin_amdgcn_sched_barrier(0);
            }
        }
#pragma unroll
        for (int r = 0; r < 16; ++r) { const float f = __builtin_amdgcn_exp2f(lg2 * (float)(rg * 32 + crow(r, hi) + 1));
#pragma unroll
            for (int c = 0; c < 4; ++c) o[c][r] *= f; }
        __syncthreads();
    }
    float m_run = 0.f, l_run = 0.f;
    tile_loop<128, 2, false, false>(lds, wsf, base + C_RQ + h * 128, base + C_RK + h * 128, base + C_RV + h * 256, qpos0, vh, 2 * qb, 2, lg2, o, m_run, l_run);
    int r32e = r32, hie = hi; asm volatile("" : "+v"(r32e), "+v"(hie));
#pragma unroll
    for (int r = 0; r < 16; ++r) {
        float s1 = 0.f, s2 = 0.f;
#pragma unroll
        for (int c = 0; c < 4; ++c) { s1 += o[c][r]; s2 += o[c][r] * o[c][r]; }
        s1 = sum32(s1); s2 = sum32(s2);
        if (r32e == 0) { stats[((rg * 2 + vh) * 32 + crow(r, hie)) * 2] = s1; stats[((rg * 2 + vh) * 32 + crow(r, hie)) * 2 + 1] = s2; }
    }
    MIX_LAS float* stg = (MIX_LAS float*)(lds + wave * 16384);
#pragma unroll
    for (int r = 0; r < 16; ++r)
#pragma unroll
        for (int c = 0; c < 4; ++c) stg[crow(r, hie) * 128 + 32 * c + r32e] = o[c][r];
    __syncthreads();
    const int vg = lane & 15, colb = h * 256 + vh * 128 + vg * 8;
    const f32x4v gw0 = *(const f32x4v*)(A.gn_w + colb), gw1 = *(const f32x4v*)(A.gn_w + colb + 4), gb0 = *(const f32x4v*)(A.gn_b + colb), gb1 = *(const f32x4v*)(A.gn_b + colb + 4);
    const size_t tok0 = (size_t)b * SEQ + qpos0;
#pragma unroll
    for (int i = 0; i < 8; ++i) {
        const int q = 4 * i + (lane >> 4);
        const u32x4 gq = *(const u32x4*)(A.P + (tok0 + q) * LDP + C_RG + colb);
        const float s1 = stats[((rg * 2 + 0) * 32 + q) * 2] + stats[((rg * 2 + 1) * 32 + q) * 2], s2 = stats[((rg * 2 + 0) * 32 + q) * 2 + 1] + stats[((rg * 2 + 1) * 32 + q) * 2 + 1];
        const float mu = s1 * (1.0f / 256.0f), var = fmaxf(s2 * (1.0f / 256.0f) - mu * mu, 0.f), rs = rsqrtf(var + LN_EPS);
        const f32x4v x0 = *(const MIX_LAS f32x4v*)(stg + q * 128 + vg * 8), x1 = *(const MIX_LAS f32x4v*)(stg + q * 128 + vg * 8 + 4);
        float g[8] = {__uint_as_float(gq.x << 16), __uint_as_float(gq.x & 0xffff0000u), __uint_as_float(gq.y << 16), __uint_as_float(gq.y & 0xffff0000u),
                      __uint_as_float(gq.z << 16), __uint_as_float(gq.z & 0xffff0000u), __uint_as_float(gq.w << 16), __uint_as_float(gq.w & 0xffff0000u)};
        float y[8];
#pragma unroll
        for (int j = 0; j < 4; ++j) { y[j] = (x0[j] - mu) * rs * gw0[j] + gb0[j]; y[4 + j] = (x1[j] - mu) * rs * gw1[j] + gb1[j]; }
#pragma unroll
        for (int j = 0; j < 8; ++j) y[j] *= RET_SCALE * g[j] * __builtin_amdgcn_rcpf(1.0f + __builtin_amdgcn_exp2f(-g[j] * LOG2E));
        pg8::u32x2 w; w.x = pg8::pk4_fp8(y[0], y[1], y[2], y[3]); w.y = pg8::pk4_fp8(y[4], y[5], y[6], y[7]);
        *(pg8::u32x2*)(A.reto + (tok0 + q) * 4096 + colb) = w;
    }
    __syncthreads();
}

#ifndef RFX_NO_CROSS
#define RFX_NO_CROSS 0
#endif
#ifndef RFX_NO_INTRA
#define RFX_NO_INTRA 0
#endif
#ifndef RFX_NO_UPD
#define RFX_NO_UPD 0
#endif
#ifndef RFX_NO_OUT
#define RFX_NO_OUT 0
#endif
template <int ABL = 0> __device__ __forceinline__ void ret_fused_unit(MIX_LAS unsigned char* lds, const MixArgs& A, const bf16_t* rqkv, bf16_t* raw, float* stats, int b, int h, int vh) {
    constexpr size_t MT_ROWS = 16384;
    int tid = threadIdx.x; asm volatile("" : "+v"(tid));
    const int lane = tid & 63, r32 = lane & 31, hi = lane >> 5, wave = __builtin_amdgcn_readfirstlane(tid >> 6);
    const int rg = wave >> 1, vq = wave & 1;
    const float lg2 = log2f(1.0f - exp2f(-5.0f - (float)h)), g128 = exp2f(128.0f * lg2);
    unsigned gs[4]; gs[0] = 0x3f800000u;
#pragma unroll
    for (int q = 1; q < 4; ++q) gs[q] = __builtin_amdgcn_readfirstlane(__float_as_uint(exp2f((float)q * lg2)));
    const unsigned gs8 = __builtin_amdgcn_readfirstlane(__float_as_uint(exp2f(8.0f * lg2)));
    const char* Qg = (const char*)(rqkv + ((size_t)(h) * MT_ROWS + (size_t)b * SEQ) * 128); const char* Kg = (const char*)(rqkv + ((size_t)(16 + h) * MT_ROWS + (size_t)b * SEQ) * 128);
    const char* Vg = (const char*)(rqkv + ((size_t)(32 + 2 * h + vh) * MT_ROWS + (size_t)b * SEQ) * 128);
    constexpr int KIMG = 0, VIMG = 32768, SIMG = 65536, OIMG = 98304;
    const unsigned go0 = (unsigned)((tid >> 4) * 128 + (tid & 15) * 8) * 2u, lo0 = voff_b((unsigned)(tid >> 4), (unsigned)(tid & 15));
    constexpr size_t GSTEP = (size_t)32 * 128 * 2;
    constexpr size_t CSTEP = (size_t)128 * 128 * 2;
    u32x4 kst[4], vst[4];
#define RF_LOAD(c_) do { const size_t o_ = (size_t)(c_) * CSTEP; _Pragma("unroll") for (int i = 0; i < 4; ++i) { kst[i] = *(const u32x4*)(Kg + (o_ + i * GSTEP) + go0); vst[i] = *(const u32x4*)(Vg + (o_ + i * GSTEP) + go0); } } while (0)
#define RF_STORE() do { float kf_ = __builtin_amdgcn_exp2f(lg2c * (float)(127 - (tidc >> 4))); const float kstep_ = __builtin_amdgcn_exp2f(-32.0f * lg2c); \
        _Pragma("unroll") for (int i = 0; i < 4; ++i) { u32x4 kw_; \
            _Pragma("unroll") for (int q_ = 0; q_ < 4; ++q_) kw_[q_] = pk_bf16(__uint_as_float(kst[i][q_] << 16) * kf_, __uint_as_float(kst[i][q_] & 0xffff0000u) * kf_); \
            *(MIX_LAS u32x4*)(lds + KIMG + 8192 * i + lo0) = kw_; *(MIX_LAS u32x4*)(lds + VIMG + 8192 * i + lo0) = vst[i]; kf_ *= kstep_; } } while (0)
#define RF_LOADQ(c_) do { const char* qp_ = Qg + (size_t)(c_) * CSTEP + (size_t)(32 * rg + r32) * 128 * 2 + hi * 16; _Pragma("unroll") for (int d0 = 0; d0 < 8; ++d0) qf[d0] = *(const bf16x8*)(qp_ + d0 * 32); } while (0)
#define RF_BAR() asm volatile("s_waitcnt lgkmcnt(0)\n\ts_barrier" ::: "memory")
    const unsigned tq = (lane & 15) >> 2, tp = lane & 3, tblk = (lane >> 4) & 1;
    unsigned vperm[2][2], vnat[2][2], knat[2];
#pragma unroll
    for (int tt = 0; tt < 2; ++tt) {
        knat[tt] = voff_b(8u * hi + 4u * tt + tq, 4u * rg + 2u * tblk + (tp >> 1)) + 8u * (tp & 1u);
#pragma unroll
        for (int cc = 0; cc < 2; ++cc) {
            vperm[cc][tt] = voff_b(8u * tt + 4u * hi + tq, 4u * (2 * vq + cc) + 2u * tblk + (tp >> 1)) + 8u * (tp & 1u);
            vnat[cc][tt] = voff_b(8u * hi + 4u * tt + tq, 4u * (2 * vq + cc) + 2u * tblk + (tp >> 1)) + 8u * (tp & 1u);
        }
    }
    f32x16 sacc[2];
#pragma unroll
    for (int cc = 0; cc < 2; ++cc)
#pragma unroll
        for (int r = 0; r < 16; ++r) sacc[cc][r] = 0.f;
    { unsigned z = 0u; asm volatile("" : "+v"(z)); for (int i = tid; i < 32768 / 16; i += 512) *(MIX_LAS u32x4*)(lds + SIMG + i * 16) = (u32x4){z, z, z, z}; }
    bf16x8 qf[8];
    RF_LOAD(0); RF_LOADQ(0);
    { float lg2c = lg2; int tidc = tid; asm volatile("" : "+v"(lg2c), "+v"(tidc)); RF_STORE(); }
    RF_BAR();
    for (int c = 0; c < 16; ++c) {
        float lg2c = lg2; int hic = hi, r32c = r32, cs = c, tidc = tid; asm volatile("" : "+v"(lg2c), "+v"(hic), "+v"(r32c), "+s"(cs), "+v"(tidc));
        float lg2c_ = lg2c; (void)lg2c_;
        if (c + 1 < 16 && !(ABL & 16)) { RF_LOAD(c + 1); }
        f32x16 o[2];
#pragma unroll
        for (int cc = 0; cc < 2; ++cc)
#pragma unroll
            for (int r = 0; r < 16; ++r) o[cc][r] = 0.f;
        if (c > 0 && !(ABL & 1)) {
#pragma unroll
            for (int t = 0; t < 2; ++t)
#pragma unroll
                for (int cc = 0; cc < 2; ++cc) {
                    s16x4 lo[4], hh[4];
#pragma unroll
                    for (int ks = 0; ks < 4; ++ks) { lo[ks] = __builtin_amdgcn_ds_read_tr16_b64_v4i16((MIX_LAS s16x4*)(lds + SIMG + t * 16384 + vnat[cc][0] + 4096 * ks));
                                                     hh[ks] = __builtin_amdgcn_ds_read_tr16_b64_v4i16((MIX_LAS s16x4*)(lds + SIMG + t * 16384 + vnat[cc][1] + 4096 * ks)); }
#pragma unroll
                    for (int ks = 0; ks < 4; ++ks) { const bf16x8 vf = (bf16x8){lo[ks][0], lo[ks][1], lo[ks][2], lo[ks][3], hh[ks][0], hh[ks][1], hh[ks][2], hh[ks][3]};
                                                     o[cc] = __builtin_amdgcn_mfma_f32_32x32x16_bf16(qf[4 * t + ks], vf, o[cc], 0, 0, 0); }
                    __builtin_amdgcn_sched_barrier(0);
                }
        }
        const int qloc = 32 * rg + r32c;
#pragma unroll
        for (int kh = 0; kh < 2; ++kh) if (64 * kh <= 32 * rg + 31 && !(ABL & 2)) {
            f32x16 p0, p1;
#pragma unroll
            for (int r = 0; r < 16; ++r) { p0[r] = 0.f; p1[r] = 0.f; }
            const MIX_LAS unsigned char* ki = lds + KIMG + kh * 16384; const unsigned ka = 256u * (unsigned)r32c + 16u * ((unsigned)hic ^ ((((unsigned)r32c & 3u) << 2) | (((unsigned)r32c >> 2) & 3u)));
#pragma unroll
            for (int d0 = 0; d0 < 8; ++d0) {
                const bf16x8 a0 = *(const MIX_LAS bf16x8*)(ki + (ka ^ (32u * d0)));
                const bf16x8 a1 = *(const MIX_LAS bf16x8*)(ki + 8192 + (ka ^ (32u * d0)));
                p0 = __builtin_amdgcn_mfma_f32_32x32x16_bf16(a0, qf[d0], p0, 0, 0, 0);
                p1 = __builtin_amdgcn_mfma_f32_32x32x16_bf16(a1, qf[d0], p1, 0, 0, 0);
                if (d0 & 1) __builtin_amdgcn_sched_barrier(0);
            }
            const int kbase = 64 * kh + 4 * hic;
            if (64 * kh + 63 > 32 * rg) {
#pragma unroll
                for (int r = 0; r < 16; ++r) { const int kp = kbase + (r & 3) + 8 * (r >> 2); if (kp > qloc) p0[r] = 0.f; if (kp + 32 > qloc) p1[r] = 0.f; }
            }
            u32x4 pw[4];
#pragma unroll
            for (int j = 0; j < 4; ++j) { pw[0][j] = pk_bf16(p0[2 * j], p0[2 * j + 1]); pw[1][j] = pk_bf16(p0[8 + 2 * j], p0[9 + 2 * j]);
                                          pw[2][j] = pk_bf16(p1[2 * j], p1[2 * j + 1]); pw[3][j] = pk_bf16(p1[8 + 2 * j], p1[9 + 2 * j]); }
#pragma unroll
            for (int cc = 0; cc < 2; ++cc) {
                s16x4 lo[4], hh[4];
#pragma unroll
                for (int ks = 0; ks < 4; ++ks) { lo[ks] = __builtin_amdgcn_ds_read_tr16_b64_v4i16((MIX_LAS s16x4*)(lds + VIMG + kh * 16384 + vperm[cc][0] + 4096 * ks));
                                                 hh[ks] = __builtin_amdgcn_ds_read_tr16_b64_v4i16((MIX_LAS s16x4*)(lds + VIMG + kh * 16384 + vperm[cc][1] + 4096 * ks)); }
#pragma unroll
                for (int ks = 0; ks < 4; ++ks) { const bf16x8 vf = (bf16x8){lo[ks][0], lo[ks][1], lo[ks][2], lo[ks][3], hh[ks][0], hh[ks][1], hh[ks][2], hh[ks][3]};
                                                 o[cc] = __builtin_amdgcn_mfma_f32_32x32x16_bf16(__builtin_bit_cast(bf16x8, pw[ks]), vf, o[cc], 0, 0, 0); }
                __builtin_amdgcn_sched_barrier(0);
            }
        }
        if (c + 1 < 16 && !(ABL & 16)) { RF_LOADQ(c + 1); }
        { const size_t tok0 = (size_t)b * SEQ + (size_t)cs * 128 + 32 * rg;
          char* ob0 = (char*)(raw + ((size_t)(2 * h + vh) * MT_ROWS + tok0) * 128 + 64 * vq);
          float qa[4]; qa[0] = __builtin_amdgcn_exp2f(lg2c * (float)(32 * rg + 4 * hic - 127));
#pragma unroll
          for (int q = 1; q < 4; ++q) qa[q] = qa[q - 1] * __uint_as_float(gs8);
          if (ABL & 8) {
#pragma unroll
              for (int r = 0; r < 16; ++r) asm volatile("" :: "v"(o[0][r]), "v"(o[1][r]));
          }
          if (!(ABL & 8)) {
              MIX_LAS unsigned char* stg = lds + OIMG + wave * 4096;
              const unsigned wb = 512u * (unsigned)hic + 2u * (unsigned)r32c;
#pragma unroll
              for (int r = 0; r < 16; ++r) {
                  const unsigned cr = (r & 3) + 8 * (r >> 2);
                  const float fo = qa[r >> 2] * __uint_as_float(gs[r & 3]);
                  const unsigned pk = pk_bf16(o[0][r] * fo, o[1][r] * fo);
                  *(MIX_LAS bf16_t*)(stg + wb + cr * 128u) = (bf16_t)(pk & 0xffffu); *(MIX_LAS bf16_t*)(stg + wb + cr * 128u + 64u) = (bf16_t)(pk >> 16);
              }
              const unsigned lanec = (unsigned)r32c + 32u * (unsigned)hic;
              const unsigned ro = (lanec >> 3) * 128u + (lanec & 7u) * 16u;
              char* og = ob0 + (lanec >> 3) * 256u + (lanec & 7u) * 16u;
#pragma unroll
              for (int i = 0; i < 4; ++i) { const u32x4 w = *(const MIX_LAS u32x4*)(stg + ro + i * 1024); *(u32x4*)(og + i * 2048) = w; }
          } }
        if (!(ABL & 4))
#pragma unroll
        for (int ks8 = 0; ks8 < 8; ++ks8) {
            const MIX_LAS unsigned char* ki = lds + KIMG + (ks8 >> 2) * 16384 + (ks8 & 3) * 4096; const MIX_LAS unsigned char* vi = lds + VIMG + (ks8 >> 2) * 16384 + (ks8 & 3) * 4096;
            const s16x4 a0 = __builtin_amdgcn_ds_read_tr16_b64_v4i16((MIX_LAS s16x4*)(ki + knat[0])), a1 = __builtin_amdgcn_ds_read_tr16_b64_v4i16((MIX_LAS s16x4*)(ki + knat[1]));
            const bf16x8 af = (bf16x8){a0[0], a0[1], a0[2], a0[3], a1[0], a1[1], a1[2], a1[3]};
#pragma unroll
            for (int cc = 0; cc < 2; ++cc) {
                const s16x4 b0 = __builtin_amdgcn_ds_read_tr16_b64_v4i16((MIX_LAS s16x4*)(vi + vnat[cc][0])), b1 = __builtin_amdgcn_ds_read_tr16_b64_v4i16((MIX_LAS s16x4*)(vi + vnat[cc][1]));
                const bf16x8 bfr = (bf16x8){b0[0], b0[1], b0[2], b0[3], b1[0], b1[1], b1[2], b1[3]};
                sacc[cc] = __builtin_amdgcn_mfma_f32_32x32x16_bf16(af, bfr, sacc[cc], 0, 0, 0);
            }
            if (ks8 & 1) __builtin_amdgcn_sched_barrier(0);
        }
#pragma unroll
        for (int cc = 0; cc < 2; ++cc)
#pragma unroll
            for (int r = 0; r < 16; ++r) sacc[cc][r] *= g128;
        RF_BAR();
        if (c + 1 < 16) {
            RF_STORE();
            if (!(ABL & 32)) {
            const unsigned sa = (unsigned)(SIMG + (rg >> 1) * 16384 + (rg & 1) * 8192) + 1024u * (unsigned)hic + 16u * ((8u * vq + ((unsigned)r32c >> 3)) ^ (unsigned)hic) + 2u * ((unsigned)r32c & 7u);
#pragma unroll
            for (int cc = 0; cc < 2; ++cc)
#pragma unroll
                for (int r = 0; r < 16; r += 2) {
                    const unsigned pk = pk_bf16(sacc[cc][r], sacc[cc][r + 1]);
                    const unsigned c0 = 16u * ((4u * cc) ^ ((((unsigned)r & 3u) << 2) | (2u * (((unsigned)r >> 2) & 1u)))), c1 = 16u * ((4u * cc) ^ ((((unsigned)(r + 1) & 3u) << 2) | (2u * (((unsigned)(r + 1) >> 2) & 1u))));
                    *(MIX_LAS bf16_t*)(lds + ((sa ^ c0) + 256u * ((r & 3) + 8 * (r >> 2)))) = (bf16_t)(pk & 0xffffu);
                    *(MIX_LAS bf16_t*)(lds + ((sa ^ c1) + 256u * (((r + 1) & 3) + 8 * ((r + 1) >> 2)))) = (bf16_t)(pk >> 16);
                }
            }
        }
        RF_BAR();
    }
    __syncthreads();
#undef RF_LOAD
#undef RF_STORE
#undef RF_LOADQ
#undef RF_BAR
}
__device__ __forceinline__ void ret_norm_row(const MixArgs& A, const bf16_t* raw, const float* stats, size_t tok, int lane) {
    const bf16_t* gr = A.P + tok * LDPS + S_RG; unsigned char* orow = A.reto + tok * 4096;
#pragma unroll
    for (int j = 0; j < 8; ++j) {
        const int col = j * 512 + lane * 8;
        const u32x4 xr = *(const u32x4*)(raw + ((size_t)(col >> 7) * 16384 + tok) * 128 + (col & 127)), gq = *(const u32x4*)(gr + col);
        const f32x4v w0 = *(const f32x4v*)(A.gn_w + col), w1 = *(const f32x4v*)(A.gn_w + col + 4), b0 = *(const f32x4v*)(A.gn_b + col), b1 = *(const f32x4v*)(A.gn_b + col + 4);
        float x[8] = {__uint_as_float(xr.x << 16), __uint_as_float(xr.x & 0xffff0000u), __uint_as_float(xr.y << 16), __uint_as_float(xr.y & 0xffff0000u),
                      __uint_as_float(xr.z << 16), __uint_as_float(xr.z & 0xffff0000u), __uint_as_float(xr.w << 16), __uint_as_float(xr.w & 0xffff0000u)};
        float g[8] = {__uint_as_float(gq.x << 16), __uint_as_float(gq.x & 0xffff0000u), __uint_as_float(gq.y << 16), __uint_as_float(gq.y & 0xffff0000u),
                      __uint_as_float(gq.z << 16), __uint_as_float(gq.z & 0xffff0000u), __uint_as_float(gq.w << 16), __uint_as_float(gq.w & 0xffff0000u)};
        float s1 = 0.f, s2 = 0.f;
#pragma unroll
        for (int i = 0; i < 8; ++i) { s1 += x[i]; s2 += x[i] * x[i]; }
        s1 = sum32(s1); s2 = sum32(s2);
        const float mu = s1 * (1.0f / 256.0f), var = fmaxf(s2 * (1.0f / 256.0f) - mu * mu, 0.f), rs = rsqrtf(var + LN_EPS);
        float y[8];
#pragma unroll
        for (int i = 0; i < 4; ++i) { y[i] = (x[i] - mu) * rs * w0[i] + b0[i]; y[4 + i] = (x[4 + i] - mu) * rs * w1[i] + b1[i]; }
#pragma unroll
        for (int i = 0; i < 8; ++i) y[i] *= RET_SCALE * g[i] * __builtin_amdgcn_rcpf(1.0f + __builtin_amdgcn_exp2f(-g[i] * LOG2E));
        pg8::u32x2 w; w.x = pg8::pk4_fp8(y[0], y[1], y[2], y[3]); w.y = pg8::pk4_fp8(y[4], y[5], y[6], y[7]);
        *(pg8::u32x2*)(orow + col) = w;
    }
}
}

namespace peer {
typedef unsigned short bf16_t;
typedef short bf16x8 __attribute__((ext_vector_type(8)));
typedef float f32x16 __attribute__((ext_vector_type(16)));
typedef __bf16 bf16x2 __attribute__((ext_vector_type(2)));
__device__ __forceinline__ unsigned umax_(unsigned a, unsigned b) { return a > b ? a : b; }
__device__ __forceinline__ unsigned umin_(unsigned a, unsigned b) { return a < b ? a : b; }
__device__ __forceinline__ void sort16(unsigned (&a)[16]) {
#pragma unroll
    for (int k = 2; k <= 16; k <<= 1)
#pragma unroll
        for (int j = k >> 1; j > 0; j >>= 1)
#pragma unroll
            for (int i = 0; i < 16; ++i) { const int l = i ^ j; if (l > i) { const unsigned hi = umax_(a[i], a[l]), lo = umin_(a[i], a[l]); if ((i & k) == 0) { a[i] = hi; a[l] = lo; } else { a[i] = lo; a[l] = hi; } } }
}
__device__ __forceinline__ void merge16(unsigned (&a)[16], const unsigned (&b)[16]) {
#pragma unroll
    for (int i = 0; i < 16; ++i) a[i] = umax_(a[i], b[15 - i]);
#pragma unroll
    for (int s = 8; s > 0; s >>= 1)
#pragma unroll
        for (int i = 0; i < 16; ++i) if ((i & s) == 0) { const unsigned hi = umax_(a[i], a[i + s]), lo = umin_(a[i], a[i + s]); a[i] = hi; a[i + s] = lo; }
}
__device__ __forceinline__ void score_block(unsigned (&S)[16], const bf16_t* kp, const bf16x8 (&qf)[8], int keybase) {
    f32x16 acc;
#pragma unroll
    for (int r = 0; r < 16; ++r) acc[r] = 0.f;
#pragma unroll
    for (int ks = 0; ks < 8; ++ks) { const bf16x8 a = *(const bf16x8*)(kp + ks * 16); acc = __builtin_amdgcn_mfma_f32_32x32x16_bf16(a, qf[ks], acc, 0, 0, 0); }
#pragma unroll
    for (int r = 0; r < 16; ++r) {
        const int key = keybase + (r & 3) + 8 * (r >> 2);
        const float f = fminf(fmaxf((acc[r] + 16.0f) * 1048576.0f, 0.f), 33554431.0f);
        S[r] = ((unsigned)f << 7) | (unsigned)(127 - key);
    }
    sort16(S);
}
__device__ __forceinline__ void subkey_top16(unsigned (&Lo)[16], const bf16_t* QPt, const bf16_t* KEYS, int h, int c, int r32, int hi) {
    bf16x8 qf[8];
#pragma unroll
    for (int ks = 0; ks < 8; ++ks) qf[ks] = *(const bf16x8*)(QPt + h * 256 + c * 128 + ks * 16 + hi * 8);
    const bf16_t* kp = KEYS + ((size_t)((h * 2 + c) * 128 + r32)) * 128 + hi * 8;
    unsigned S1[16], S2[16];
    score_block(Lo, kp, qf, 4 * hi);
    score_block(S1, kp + 32 * 128, qf, 32 + 4 * hi);
    merge16(Lo, S1);
    score_block(S1, kp + 64 * 128, qf, 64 + 4 * hi);
    score_block(S2, kp + 96 * 128, qf, 96 + 4 * hi);
    merge16(S1, S2); merge16(Lo, S1);
    const unsigned pm = 0u - (unsigned)hi;
#pragma unroll
    for (int i = 0; i < 16; ++i) { auto rr = __builtin_amdgcn_permlane32_swap(Lo[i], Lo[i], false, false); S1[i] = (rr[0] & pm) | (rr[1] & ~pm); }
    merge16(Lo, S1);
}
#define PEER_LAS __attribute__((address_space(3)))
constexpr int ENT_PITCH = 132;
__device__ __forceinline__ void topk_item(const bf16_t* QP, const bf16_t* KEYS, PEER_LAS unsigned* ent, int g, int h) {
    const int lane = threadIdx.x & 63, r32 = lane & 31, hi = lane >> 5;
    const size_t tok = (size_t)g * 32 + r32;
    unsigned L0[16], L1[16];
    subkey_top16(L0, QP + tok * 2048, KEYS, h, 0, r32, hi);
    subkey_top16(L1, QP + tok * 2048, KEYS, h, 1, r32, hi);
    unsigned C0[16], C1[16], C2[16], C3[16];
#define CAND(a, b) ((((((L0[a] >> 7) + (L1[b] >> 7)) >> 8) << 14)) | ((127u - (L0[a] & 127u)) << 7) | (127u - (L1[b] & 127u)))
#pragma unroll
    for (int b = 0; b < 16; ++b) C0[b] = CAND(0, b);
#pragma unroll
    for (int b = 0; b < 8; ++b) C1[b] = CAND(1, b);
#pragma unroll
    for (int b = 0; b < 5; ++b) C1[8 + b] = CAND(2, b);
    C1[13] = CAND(3, 0); C1[14] = CAND(3, 1); C1[15] = CAND(3, 2);
    C2[0] = CAND(3, 3); C2[1] = CAND(4, 0); C2[2] = CAND(4, 1); C2[3] = CAND(4, 2); C2[4] = CAND(5, 0); C2[5] = CAND(5, 1); C2[6] = CAND(6, 0); C2[7] = CAND(6, 1);
    C2[8] = CAND(7, 0); C2[9] = CAND(7, 1); C2[10] = CAND(8, 0); C2[11] = CAND(9, 0); C2[12] = CAND(10, 0); C2[13] = CAND(11, 0); C2[14] = CAND(12, 0); C2[15] = CAND(13, 0);
    C3[0] = CAND(14, 0); C3[1] = CAND(15, 0);
#pragma unroll
    for (int b = 2; b < 16; ++b) C3[b] = 0u;
#undef CAND
    sort16(C0); sort16(C1); sort16(C2); sort16(C3);
    merge16(C0, C1); merge16(C2, C3); merge16(C0, C2);
    float sc[16], sum;
    const float mx = (float)(C0[0] >> 14) * (1.0f / 4096.0f); sum = 0.f;
#pragma unroll
    for (int k = 0; k < 16; ++k) { sc[k] = __expf((float)(C0[k] >> 14) * (1.0f / 4096.0f) - mx); sum += sc[k]; }
    const float inv = 1.0f / sum;
    const unsigned hmask = 0u - (unsigned)hi;
#pragma unroll
    for (int k = 0; k < 8; ++k) {
        const unsigned key = (C0[8 + k] & hmask) | (C0[k] & ~hmask); const float gt = __uint_as_float((__float_as_uint(sc[8 + k]) & hmask) | (__float_as_uint(sc[k]) & ~hmask)) * inv;
        ent[r32 * ENT_PITCH + h * 16 + hi * 8 + k] = ((key & 16383u) << 16) | (__float_as_uint(gt) >> 16);
    }
}
__device__ __forceinline__ void topk_store(const PEER_LAS unsigned* ent, unsigned char* G8, int g) {
    const int tid = threadIdx.x, tok = tid >> 4;
    const PEER_LAS unsigned* row = ent + tok * ENT_PITCH;
#pragma unroll 1
    for (int i = 0; i < 8; ++i) {
        const int j = (tid & 15) + 16 * i;
        const unsigned me = row[j], e = me >> 16; float sum = 0.f; bool dup = false;
        for (int q = 0; q < 128; q += 4) {
            const unsigned w0 = row[q], w1 = row[q + 1], w2 = row[q + 2], w3 = row[q + 3];
            if ((w0 >> 16) == e) { sum += __uint_as_float(w0 << 16); dup |= (q < j); }
            if ((w1 >> 16) == e) { sum += __uint_as_float(w1 << 16); dup |= (q + 1 < j); }
            if ((w2 >> 16) == e) { sum += __uint_as_float(w2 << 16); dup |= (q + 2 < j); }
            if ((w3 >> 16) == e) { sum += __uint_as_float(w3 << 16); dup |= (q + 3 < j); }
        }
        if (!dup) G8[((size_t)g * 32 + tok) * NE + e] = (unsigned char)(pg8::pk4_fp8(sum * 64.0f, 0.f, 0.f, 0.f) & 0xffu);
    }
}
typedef unsigned u32x4p __attribute__((ext_vector_type(4)));
__device__ __forceinline__ void topk_store_dense(const PEER_LAS unsigned* ent, PEER_LAS unsigned char* rowbuf, unsigned char* G8, int g) {
    const int tid = threadIdx.x, tl = tid >> 7, j = tid & 127;
    PEER_LAS unsigned* accw = (PEER_LAS unsigned*)(rowbuf - 2048) + tl * 128;
#define PEER_LBAR() asm volatile("s_waitcnt lgkmcnt(0)\n\ts_barrier" ::: "memory")
#pragma unroll 1
    for (int rd = 0; rd < 8; ++rd) {
        { unsigned zz = 0u; asm volatile("" : "+v"(zz)); const u32x4p z = {zz, zz, zz, zz};
#pragma unroll
          for (int i = 0; i < 8; ++i) *(PEER_LAS u32x4p*)(rowbuf + (tid + 512 * i) * 16) = z; }
        const unsigned me = ent[(rd * 4 + tl) * ENT_PITCH + j], e = me >> 16;
        const unsigned gfix = (unsigned)(__uint_as_float(me << 16) * 16777216.0f);
        PEER_LAS unsigned char* cell = rowbuf + tl * 16384 + e;
        PEER_LBAR();
        *cell = (unsigned char)(j + 1); accw[j] = gfix;
        PEER_LBAR();
        const int own = (int)*cell - 1;
        if (own != j) __hip_atomic_fetch_add(accw + own, gfix, __ATOMIC_RELAXED, __HIP_MEMORY_SCOPE_WORKGROUP);
        PEER_LBAR();
        if (own == j) *cell = (unsigned char)(pg8::pk4_fp8((float)accw[j] * (64.0f / 16777216.0f), 0.f, 0.f, 0.f) & 0xffu);
        PEER_LBAR();
        { unsigned char* dst = G8 + ((size_t)g * 32 + rd * 4) * NE;
#pragma unroll
          for (int i = 0; i < 8; ++i) { const u32x4p w = *(const PEER_LAS u32x4p*)(rowbuf + (tid + 512 * i) * 16); *(u32x4p*)(dst + (size_t)(tid + 512 * i) * 16) = w; } }
        PEER_LBAR();
    }
#undef PEER_LBAR
}
}

constexpr int NWAVES = 8;
#ifndef MK_N_LAUNCHES
#define MK_N_LAUNCHES 1
#endif
constexpr int N_PHASES = 11;
constexpr int N_LAUNCHES = MK_N_LAUNCHES;
static_assert(N_LAUNCHES == 1 || N_LAUNCHES == N_PHASES, "MK_N_LAUNCHES is 1 or 11");

constexpr size_t MiB = 1u << 20;
constexpr size_t WS_CTL = 0, CTL_ZERO_BYTES = 64 * 1024;
constexpr size_t WS_KEYS = 1 * MiB;
constexpr size_t WS_WDA = 2 * MiB, WS_WRET = 18 * MiB, WS_WOUT = 50 * MiB, WS_WQ = 82 * MiB, WS_UB = 98 * MiB, WS_VT = 226 * MiB;
constexpr size_t WS_XB = 354 * MiB, WS_WIN = 482 * MiB, WS_PROJ = 690 * MiB, WS_X1F8 = 1522 * MiB, WS_END = 1586 * MiB;
constexpr size_t WS_A8 = 354 * MiB;
#ifndef FP6_P1
#define FP6_P1 1
#endif
#ifndef FP6_P8
#define FP6_P8 1
#endif
constexpr float X_SCALE = 2.0f, X1_SCALE = 2.0f, WIN6_SCALE = 128.0f, U6_SCALE = 128.0f, WQ6_SCALE = 128.0f;
constexpr float WIN_SCALE = 64.0f, WDA_SCALE = 64.0f, WRET_SCALE = 128.0f, WOUT_SCALE = 128.0f, M_SCALE = 16.0f;
constexpr float U_SCALE = 64.0f, V_SCALE = 8.0f, A_SCALE = 64.0f;
#ifndef PROBE_ABL
#define PROBE_ABL 0
#endif
#ifndef RET_FUSED
#define RET_FUSED 1
#endif
constexpr size_t WS_RQKV = 1266 * MiB;
constexpr size_t WS_RSTATS = 642 * MiB;
constexpr size_t WS_STATE = 450 * MiB;
constexpr size_t WS_ATTO = 354 * MiB, WS_RETO = 386 * MiB, WS_MERGED = 450 * MiB, WS_MERGED8 = 578 * MiB;
constexpr size_t WS_Z1 = 1266 * MiB, WS_X1B = 818 * MiB, WS_QP = 946 * MiB, WS_G = 1010 * MiB;
static_assert(WS_A8 + (size_t)MT * NE <= WS_PROJ && WS_MERGED + (size_t)MT * DM * 2 <= WS_MERGED8 && WS_MERGED8 + (size_t)MT * DM <= WS_PROJ && WS_G + (size_t)MT * NE * 2 <= WS_X1F8 && WS_WIN + (size_t)LDP * DM * 2 <= WS_PROJ && WS_PROJ + (size_t)MT * LDP * 2 <= WS_X1F8, "d_ws map");
constexpr int CW_BAR = 1024;

constexpr int RING_BYTES = 131072, LDSCTL_OFF = RING_BYTES, MISC_OFF = LDSCTL_OFF + 320, LDS_BYTES = 147456;

#define GAS __attribute__((address_space(1)))
#define LAS __attribute__((address_space(3)))
typedef unsigned short bf16;
typedef unsigned v4u __attribute__((ext_vector_type(4)));
typedef float f32x4 __attribute__((ext_vector_type(4)));
#define LDS_WAIT() asm volatile("s_waitcnt lgkmcnt(0)" ::: "memory")
__device__ __forceinline__ unsigned f2bf(float f) { unsigned u = __builtin_bit_cast(unsigned, f); return (u + 0x7fffu + ((u >> 16) & 1u)) >> 16; }
__device__ __forceinline__ unsigned pk2(float lo, float hi) { return f2bf(lo) | (f2bf(hi) << 16); }

#define XB_TMO      128
#define XB_XCNT(j)  (256  + 64 * (j))
#define XB_XSUB(j)  (1280 + 64 * (j))
#define XB_XGEN(j)  (2304 + 64 * (j))
#define XB_TOP      3328
#define XB_TOPGEN   3392
#define XCD_BAR_WORDS 3456
#define XB_SPIN_CAP (1u << 18)

__device__ __forceinline__ unsigned xb_ld(unsigned* p)              { return __hip_atomic_load(p, __ATOMIC_RELAXED, __HIP_MEMORY_SCOPE_AGENT); }
__device__ __forceinline__ unsigned xb_add(unsigned* p, unsigned v) { return __hip_atomic_fetch_add(p, v, __ATOMIC_RELAXED, __HIP_MEMORY_SCOPE_AGENT); }
__device__ __forceinline__ unsigned xb_xcc_id() { return (unsigned)__builtin_amdgcn_s_getreg((3 << 11) | 20) & 0xFu; }
#define XB_SPIN(cond, bar) do { unsigned _sp = 0; while (cond) { __builtin_amdgcn_s_sleep(1); \
    if ((++_sp & 255u) == 0u) { if (xb_ld(&(bar)[XB_TMO])) break; if (_sp > XB_SPIN_CAP) { atomicAdd(&(bar)[XB_TMO], 1u); break; } } } } while (0)

struct XcdBarrier {
    unsigned* bar; unsigned x;
    volatile LAS unsigned* st;
};

__device__ __forceinline__ XcdBarrier xcd_barrier_post(unsigned* bar, volatile LAS unsigned* st) {
    XcdBarrier b; b.bar = bar; b.x = xb_xcc_id(); b.st = st;
    if (threadIdx.x == 0) (void)xb_add(&bar[XB_XCNT(b.x)], 1u);
    return b;
}
__device__ __forceinline__ void xcd_barrier_complete(unsigned* bar, unsigned x, unsigned& nloc, unsigned& nx) {
    const unsigned G = gridDim.x * gridDim.y * gridDim.z;
    unsigned sum, cnt, mine, sp = 0u;
    for (;;) {
        sum = 0u; cnt = 0u; mine = 0u;
#pragma unroll
        for (unsigned j = 0; j < 16; ++j) { const unsigned c = xb_ld(&bar[XB_XCNT(j)]); sum += c; cnt += (c > 0u) ? 1u : 0u; mine = (j == x) ? c : mine; }
        if (sum == G) break;
        __builtin_amdgcn_s_sleep(1);
        if ((++sp & 255u) == 0u) { if (xb_ld(&bar[XB_TMO])) break; if (sp > XB_SPIN_CAP) { atomicAdd(&bar[XB_TMO], 1u); break; } }
    }
    nloc = mine > 0u ? mine : 1u; nx = cnt > 0u ? cnt : 1u;
}

__device__ __forceinline__ void xcd_barrier(const XcdBarrier& b) {
    asm volatile("s_waitcnt vmcnt(0)" ::: "memory");
    __syncthreads();
    if (threadIdx.x == 0) {
        unsigned* bar = b.bar;
        __builtin_amdgcn_s_waitcnt(0);
        unsigned nloc = b.st[0], nx = b.st[1];
        if (nloc == 0u) { xcd_barrier_complete(bar, b.x, nloc, nx); b.st[0] = nloc; b.st[1] = nx; }
        const unsigned old = xb_add(&bar[XB_XSUB(b.x)], 1u);
        const unsigned gen = old / nloc;
        if (old + 1u == (gen + 1u) * nloc) {
            __builtin_amdgcn_fence(__ATOMIC_RELEASE, "agent");
            asm volatile("s_waitcnt vmcnt(0)" ::: "memory");
            const unsigned og = xb_add(&bar[XB_TOP], 1u);
            const unsigned tg = og / nx;
            if (og + 1u == (tg + 1u) * nx) xb_add(&bar[XB_TOPGEN], 1u);
            else XB_SPIN(xb_ld(&bar[XB_TOPGEN]) == tg, bar);
            __builtin_amdgcn_fence(__ATOMIC_ACQUIRE, "agent");
            xb_add(&bar[XB_XGEN(b.x)], 1u);
            asm volatile("s_waitcnt vmcnt(0)" ::: "memory");
        } else {
            XB_SPIN(xb_ld(&bar[XB_XGEN(b.x)]) == gen, bar);
            __builtin_amdgcn_fence(__ATOMIC_ACQUIRE, "agent");
            asm volatile("s_waitcnt vmcnt(0)" ::: "memory");
        }
    }
    __syncthreads();
}


struct Frame {
    LAS unsigned char* lds; volatile LAS unsigned* MISC; unsigned* ctl;
    int tid, lane, wave, vcu, G;
};
__device__ __forceinline__ float wave_sum(float v) {
#pragma unroll
    for (int o = 1; o < 64; o <<= 1) v += __shfl_xor(v, o);
    return v;
}
__device__ __forceinline__ void p0_transpose_item(const float* W, int K, int N, bf16* WT, LAS float* scr, int item, int lane, float scale) {
    const int nblk = N / 32, kb = item / nblk, nb = item % nblk, k0 = 64 * kb, n0 = 32 * nb;
#pragma unroll 8
    for (int i = 0; i < 32; ++i) { const int kk = 2 * i + (lane >> 5); scr[kk * 33 + (lane & 31)] = W[(size_t)(k0 + kk) * N + n0 + (lane & 31)] * scale; }
    LDS_WAIT(); asm volatile("" ::: "memory");
    const int c = lane & 7;
#pragma unroll
    for (int j = 0; j < 4; ++j) { const int n = (lane >> 3) + 8 * j; const LAS float* s = scr + (8 * c) * 33 + n;
        v4u o; o.x = pk2(s[0 * 33], s[1 * 33]); o.y = pk2(s[2 * 33], s[3 * 33]); o.z = pk2(s[4 * 33], s[5 * 33]); o.w = pk2(s[6 * 33], s[7 * 33]);
        *(GAS v4u*)(WT + (size_t)(n0 + n) * K + k0 + 8 * c) = o; }
    LDS_WAIT(); asm volatile("" ::: "memory");
}
__device__ __forceinline__ void p0_transpose_item_f8(const float* W, int K, int N, unsigned char* WT, LAS float* scr, int item, int lane, float scale) {
    const int nblk = N / 32, kb = item / nblk, nb = item % nblk, k0 = 64 * kb, n0 = 32 * nb;
#pragma unroll 8
    for (int i = 0; i < 32; ++i) { const int kk = 2 * i + (lane >> 5); scr[kk * 33 + (lane & 31)] = W[(size_t)(k0 + kk) * N + n0 + (lane & 31)] * scale; }
    LDS_WAIT(); asm volatile("" ::: "memory");
    const int c = lane & 7;
#pragma unroll
    for (int j = 0; j < 4; ++j) { const int n = (lane >> 3) + 8 * j; const LAS float* s = scr + (8 * c) * 33 + n;
        pg8::u32x2 o; o.x = pg8::pk4_fp8(s[0 * 33], s[1 * 33], s[2 * 33], s[3 * 33]); o.y = pg8::pk4_fp8(s[4 * 33], s[5 * 33], s[6 * 33], s[7 * 33]);
        *(GAS pg8::u32x2*)(WT + (size_t)(n0 + n) * K + k0 + 8 * c) = o; }
    LDS_WAIT(); asm volatile("" ::: "memory");
}
__device__ __forceinline__ void p0_transpose_item_f6(const float* W, int K, int N, unsigned char* WT, LAS float* scr, int item, int lane, float scale) {
    const int nblk = N / 32, kb = item / nblk, nb = item % nblk, k0 = 64 * kb, n0 = 32 * nb;
#pragma unroll 8
    for (int i = 0; i < 32; ++i) { const int kk = 2 * i + (lane >> 5); scr[kk * 33 + (lane & 31)] = W[(size_t)(k0 + kk) * N + n0 + (lane & 31)] * scale; }
    LDS_WAIT(); asm volatile("" ::: "memory");
    const int n = lane & 31, hf = lane >> 5; float x[32];
#pragma unroll
    for (int i = 0; i < 32; ++i) x[i] = scr[(32 * hf + i) * 33 + n];
    pg8::u32x4 lo, hi; pg8::cvt_block_fp6(x, lo, hi);
    GAS pg8::u32x4* o = (GAS pg8::u32x4*)(WT + (size_t)(n0 + n) * K + k0 + 32 * hf); o[0] = lo; o[1] = hi;
    LDS_WAIT(); asm volatile("" ::: "memory");
}
__device__ __forceinline__ void cvt_flat_f6(const float* src, unsigned char* dst, size_t n32, size_t gt, size_t gs, float scale) {
    for (size_t i = gt; i < n32; i += gs) { float x[32];
#pragma unroll
        for (int j = 0; j < 8; ++j) { const f32x4 v = *(const f32x4*)(src + i * 32 + 4 * j) * scale; x[4 * j] = v[0]; x[4 * j + 1] = v[1]; x[4 * j + 2] = v[2]; x[4 * j + 3] = v[3]; }
        pg8::u32x4 lo, hi; pg8::cvt_block_fp6(x, lo, hi); pg8::u32x4* o = (pg8::u32x4*)(dst + i * 32); o[0] = lo; o[1] = hi; }
}
__device__ __forceinline__ void cvt_flat_f6_lds(const float* src, unsigned char* dst, int nwb, int gw, int ngw, int lane, LAS unsigned char* scr, float scale) {
    for (int wb = gw; wb < nwb; wb += ngw) {
        const float* s = src + (size_t)wb * 2048;
#pragma unroll
        for (int j = 0; j < 8; ++j) { const int piece = j * 64 + lane; const f32x4 v = *(const f32x4*)(s + piece * 4) * scale; *(LAS f32x4*)(scr + (piece >> 3) * 144 + (piece & 7) * 16) = v; }
        LDS_WAIT(); asm volatile("" ::: "memory");
        float x[32];
#pragma unroll
        for (int p = 0; p < 8; ++p) { const f32x4 t = *(const LAS f32x4*)(scr + lane * 144 + p * 16); x[4 * p] = t[0]; x[4 * p + 1] = t[1]; x[4 * p + 2] = t[2]; x[4 * p + 3] = t[3]; }
        pg8::u32x4 lo, hi; pg8::cvt_block_fp6(x, lo, hi); pg8::u32x4* o = (pg8::u32x4*)(dst + ((size_t)wb * 64 + lane) * 32); o[0] = lo; o[1] = hi;
        LDS_WAIT(); asm volatile("" ::: "memory");
    }
}
__device__ __forceinline__ void cvt_flat_f8(const float* src, unsigned char* dst, size_t n16, size_t gt, size_t gs, float scale) {
    for (size_t i = gt; i < n16; i += gs) { const f32x4 a = *(const f32x4*)(src + i * 16) * scale, b = *(const f32x4*)(src + i * 16 + 4) * scale, c = *(const f32x4*)(src + i * 16 + 8) * scale, e = *(const f32x4*)(src + i * 16 + 12) * scale;
        v4u o; o.x = pg8::pk4_fp8(a[0], a[1], a[2], a[3]); o.y = pg8::pk4_fp8(b[0], b[1], b[2], b[3]); o.z = pg8::pk4_fp8(c[0], c[1], c[2], c[3]); o.w = pg8::pk4_fp8(e[0], e[1], e[2], e[3]); *(v4u*)(dst + i * 16) = o; }
}
__device__ __forceinline__ void cvt_flat(const float* src, bf16* dst, size_t n8, size_t gt, size_t gs) {
    for (size_t i = gt; i < n8; i += gs) { const f32x4 a = *(const f32x4*)(src + i * 8), b = *(const f32x4*)(src + i * 8 + 4);
        v4u o; o.x = pk2(a[0], a[1]); o.y = pk2(a[2], a[3]); o.z = pk2(b[0], b[1]); o.w = pk2(b[2], b[3]); *(v4u*)(dst + i * 8) = o; }
}
__device__ __forceinline__ void ln_affine(f32x4 (&wv)[16], f32x4 (&bv)[16], const float* w, const float* b, int lane) {
#pragma unroll
    for (int j = 0; j < 8; ++j) { const int col = j * 512 + lane * 8; wv[2 * j] = *(const f32x4*)(w + col); wv[2 * j + 1] = *(const f32x4*)(w + col + 4); bv[2 * j] = *(const f32x4*)(b + col); bv[2 * j + 1] = *(const f32x4*)(b + col + 4); }
}
template <bool OUTF32> __device__ __forceinline__ void ln_row(const bf16* zrow, const f32x4 (&wv)[16], const f32x4 (&bv)[16], void* orow, unsigned char* o8row, int lane, LAS unsigned char* scr) {
    float x[64]; float s = 0.f;
#pragma unroll
    for (int j = 0; j < 8; ++j) { const v4u v = *(const v4u*)(zrow + j * 512 + lane * 8);
        x[8 * j + 0] = __uint_as_float(v.x << 16); x[8 * j + 1] = __uint_as_float(v.x & 0xffff0000u); x[8 * j + 2] = __uint_as_float(v.y << 16); x[8 * j + 3] = __uint_as_float(v.y & 0xffff0000u);
        x[8 * j + 4] = __uint_as_float(v.z << 16); x[8 * j + 5] = __uint_as_float(v.z & 0xffff0000u); x[8 * j + 6] = __uint_as_float(v.w << 16); x[8 * j + 7] = __uint_as_float(v.w & 0xffff0000u); }
#pragma unroll
    for (int i = 0; i < 64; ++i) s += x[i];
    const float mean = wave_sum(s) * (1.0f / 4096.0f); float q = 0.f;
#pragma unroll
    for (int i = 0; i < 64; ++i) { x[i] -= mean; q += x[i] * x[i]; }
    const float rstd = rsqrtf(wave_sum(q) * (1.0f / 4096.0f) + LN_EPS);
#pragma unroll
    for (int j = 0; j < 8; ++j) { const int col = j * 512 + lane * 8;
        const f32x4 w0 = wv[2 * j], w1 = wv[2 * j + 1], b0 = bv[2 * j], b1 = bv[2 * j + 1];
        float y[8];
#pragma unroll
        for (int i = 0; i < 4; ++i) { y[i] = x[8 * j + i] * rstd * w0[i] + b0[i]; y[4 + i] = x[8 * j + 4 + i] * rstd * w1[i] + b1[i]; }
        if (OUTF32) { *(f32x4*)((float*)orow + col) = (f32x4){y[0], y[1], y[2], y[3]}; *(f32x4*)((float*)orow + col + 4) = (f32x4){y[4], y[5], y[6], y[7]}; }
        else { v4u o; o.x = pk2(y[0], y[1]); o.y = pk2(y[2], y[3]); o.z = pk2(y[4], y[5]); o.w = pk2(y[6], y[7]); *(v4u*)((bf16*)orow + col) = o;
               if (FP6_P8) *(LAS v4u*)(scr + (j * 16 + (lane >> 2)) * 80 + (lane & 3) * 16) = o;
               else { pg8::u32x2 o8; o8.x = pg8::pk4_fp8(y[0], y[1], y[2], y[3]); o8.y = pg8::pk4_fp8(y[4], y[5], y[6], y[7]); *(pg8::u32x2*)(o8row + col) = o8; } } }
    if (!OUTF32 && FP6_P8) {
        LDS_WAIT(); asm volatile("" ::: "memory");
#pragma unroll
        for (int blk = 0; blk < 2; ++blk) { float xb[32];
#pragma unroll
            for (int j = 0; j < 4; ++j) { const v4u v = *(const LAS v4u*)(scr + (2 * lane + blk) * 80 + j * 16);
                xb[8 * j + 0] = __uint_as_float(v.x << 16) * X1_SCALE; xb[8 * j + 1] = __uint_as_float(v.x & 0xffff0000u) * X1_SCALE; xb[8 * j + 2] = __uint_as_float(v.y << 16) * X1_SCALE; xb[8 * j + 3] = __uint_as_float(v.y & 0xffff0000u) * X1_SCALE;
                xb[8 * j + 4] = __uint_as_float(v.z << 16) * X1_SCALE; xb[8 * j + 5] = __uint_as_float(v.z & 0xffff0000u) * X1_SCALE; xb[8 * j + 6] = __uint_as_float(v.w << 16) * X1_SCALE; xb[8 * j + 7] = __uint_as_float(v.w & 0xffff0000u) * X1_SCALE; }
            pg8::u32x4 lo, hi; pg8::cvt_block_fp6(xb, lo, hi); pg8::u32x4* o = (pg8::u32x4*)(o8row + 64 * lane + 32 * blk); o[0] = lo; o[1] = hi; }
        LDS_WAIT(); asm volatile("" ::: "memory");
    }
}

struct Args { const float* in[17]; float* out; unsigned char* ws; int ph_lo, ph_hi, li, pad; };
__global__ void __launch_bounds__(NWAVES * 64, 2) mk_fwd(Args args) {
    extern __shared__ __attribute__((aligned(16))) unsigned char lds[];
    Frame F;
    F.lds = (LAS unsigned char*)lds; F.MISC = (volatile LAS unsigned*)(F.lds + MISC_OFF);
    F.tid = threadIdx.x; F.lane = F.tid & 63; F.wave = __builtin_amdgcn_readfirstlane(F.tid >> 6);
    F.G = gridDim.x; { const int bx = blockIdx.x; F.vcu = (F.G % 8 == 0) ? (bx % 8) * (F.G / 8) + bx / 8 : bx; }
    unsigned char* ws = args.ws;
    F.ctl = (unsigned*)(ws + WS_CTL);
    for (int u = F.tid; u < (LDS_BYTES - LDSCTL_OFF) / 4; u += NWAVES * 64) ((LAS unsigned*)(F.lds + LDSCTL_OFF))[u] = 0u;
    __syncthreads();
    XcdBarrier bar; bar.bar = F.ctl + CW_BAR; bar.x = 0; bar.st = nullptr;
    if (N_LAUNCHES == 1) bar = xcd_barrier_post(F.ctl + CW_BAR, F.MISC + 8);
#define GRID_BAR() do { if (N_LAUNCHES == 1) xcd_barrier(bar); } while (0)
    const int lo = args.ph_lo, hi = args.ph_hi;
#ifndef PH_MASK
#define PH_MASK 0x7ff
#endif
#define IN(k) (((PH_MASK >> (k)) & 1) && lo <= (k) && (k) < hi)
#ifndef REP_MASK
#define REP_MASK 0
#endif
#ifndef MIX_VAR
#define MIX_VAR 0
#endif
#ifndef STAG_TICKS
#define STAG_TICKS 600
#endif
#ifndef STAG_NG
#define STAG_NG 4
#endif
#define REPS(k) _Pragma("unroll") for (int rep_ = 0; rep_ < 1 + ((REP_MASK >> (k)) & 1); ++rep_)
    const float* x = args.in[0]; const float* w_in = args.in[1]; const float* da_lambda = args.in[2]; const float* da_subln_w = args.in[3]; const float* w_da_out = args.in[4];
    const float* ret_gn_w = args.in[5]; const float* ret_gn_b = args.in[6]; const float* w_ret_out = args.in[7]; const float* w_out = args.in[8];
    const float* ln1_w = args.in[9]; const float* ln1_b = args.in[10]; const float* peer_wq = args.in[11]; const float* peer_keys = args.in[12];
    const float* peer_u = args.in[13]; const float* peer_v = args.in[14]; const float* ln2_w = args.in[15]; const float* ln2_b = args.in[16];
    bf16* KEYS = (bf16*)(ws + WS_KEYS); bf16* WDA = (bf16*)(ws + WS_WDA); bf16* WRET = (bf16*)(ws + WS_WRET); bf16* WOUT = (bf16*)(ws + WS_WOUT); bf16* WQ = (bf16*)(ws + WS_WQ);
    bf16* UB = (bf16*)(ws + WS_UB); bf16* VT = (bf16*)(ws + WS_VT); bf16* XB = (bf16*)(ws + WS_XB); bf16* WIN = (bf16*)(ws + WS_WIN); bf16* PROJ = (bf16*)(ws + WS_PROJ);
    unsigned char* ATTO = ws + WS_ATTO; unsigned char* RETO = ws + WS_RETO; bf16* MERGED = (bf16*)(ws + WS_MERGED); unsigned char* MERGED8 = ws + WS_MERGED8;
    unsigned char* U8 = ws + WS_UB; unsigned char* VT8 = ws + WS_VT; unsigned char* A8 = ws + WS_A8; unsigned char* X1F8 = ws + WS_X1F8;
    bf16* Z1 = (bf16*)(ws + WS_Z1); bf16* X1B = (bf16*)(ws + WS_X1B); bf16* QP = (bf16*)(ws + WS_QP); bf16* GM = (bf16*)(ws + WS_G);
    const int gw = F.vcu * NWAVES + F.wave, NGW = F.G * NWAVES;
    const size_t gt = (size_t)F.vcu * (NWAVES * 64) + F.tid, gs = (size_t)F.G * (NWAVES * 64);

    if (IN(0)) {
        LAS float* scr = (LAS float*)(F.lds + F.wave * 16384);
        constexpr int I_IN = (DM / 64) * (LDP / 32), I_DA = (2048 / 64) * (DM / 32), I_RET = (DM / 64) * (DM / 32), I_OUT = I_RET, I_Q = (DM / 64) * (2048 / 32), I_V = (NE / 64) * (DM / 32);
        constexpr int NITEMS = I_IN + I_DA + I_RET + I_OUT + I_Q + I_V;
        for (int it = gw; it < NITEMS; it += NGW) {
            int r = it;
#if FP6_P1
            if (r < I_IN) { p0_transpose_item_f6(w_in, DM, LDP, (unsigned char*)WIN, scr, r, F.lane, WIN6_SCALE); continue; } r -= I_IN;
#else
            if (r < I_IN) { const int n0 = 32 * (r % (LDP / 32)); const float sc = (n0 < 2048) ? 0.125f * LOG2E : ((n0 >= C_RK && n0 < C_RV) ? 0.08838834764831845f : 1.0f);
                            p0_transpose_item_f8(w_in, DM, LDP, (unsigned char*)WIN, scr, r, F.lane, sc * WIN_SCALE); continue; } r -= I_IN;
#endif
            if (r < I_DA) { p0_transpose_item_f8(w_da_out, 2048, DM, (unsigned char*)WDA, scr, r, F.lane, WDA_SCALE); continue; } r -= I_DA;
            if (r < I_RET) { p0_transpose_item_f8(w_ret_out, DM, DM, (unsigned char*)WRET, scr, r, F.lane, WRET_SCALE); continue; } r -= I_RET;
            if (r < I_OUT) { p0_transpose_item_f8(w_out, DM, DM, (unsigned char*)WOUT, scr, r, F.lane, WOUT_SCALE); continue; } r -= I_OUT;
            if (r < I_Q) { p0_transpose_item_f6(peer_wq, DM, 2048, (unsigned char*)WQ, scr, r, F.lane, WQ6_SCALE); continue; } r -= I_Q;
            p0_transpose_item_f8(peer_v, NE, DM, VT8, scr, r, F.lane, V_SCALE);
        }
#if FP6_P1
        cvt_flat_f6_lds(x, (unsigned char*)XB, MT * (DM / 2048), gw, NGW, F.lane, (LAS unsigned char*)scr, X_SCALE);
#else
        cvt_flat_f8(x, (unsigned char*)XB, (size_t)MT * DM / 16, gt, gs, 1.0f);
#endif
#if FP6_P8
        cvt_flat_f6_lds(peer_u, U8, NE * (DM / 2048), gw, NGW, F.lane, (LAS unsigned char*)scr, U6_SCALE);
#else
        cvt_flat_f8(peer_u, U8, (size_t)NE * DM / 16, gt, gs, U_SCALE);
#endif
        cvt_flat(peer_keys, KEYS, (size_t)8 * 2 * 128 * 128 / 8, gt, gs);
        GRID_BAR();
#if (REP_MASK & 1)
        scr = (LAS float*)(F.lds + F.wave * 16384);
        for (int it = gw; it < NITEMS; it += NGW) {
            int r = it;
#if FP6_P1
            if (r < I_IN) { p0_transpose_item_f6(w_in, DM, LDP, (unsigned char*)WIN, scr, r, F.lane, WIN6_SCALE); continue; } r -= I_IN;
#else
            if (r < I_IN) { const int n0 = 32 * (r % (LDP / 32)); const float sc = (n0 < 2048) ? 0.125f * LOG2E : ((n0 >= C_RK && n0 < C_RV) ? 0.08838834764831845f : 1.0f);
                            p0_transpose_item_f8(w_in, DM, LDP, (unsigned char*)WIN, scr, r, F.lane, sc * WIN_SCALE); continue; } r -= I_IN;
#endif
            if (r < I_DA) { p0_transpose_item_f8(w_da_out, 2048, DM, (unsigned char*)WDA, scr, r, F.lane, WDA_SCALE); continue; } r -= I_DA;
            if (r < I_RET) { p0_transpose_item_f8(w_ret_out, DM, DM, (unsigned char*)WRET, scr, r, F.lane, WRET_SCALE); continue; } r -= I_RET;
            if (r < I_OUT) { p0_transpose_item_f8(w_out, DM, DM, (unsigned char*)WOUT, scr, r, F.lane, WOUT_SCALE); continue; } r -= I_OUT;
            if (r < I_Q) { p0_transpose_item_f6(peer_wq, DM, 2048, (unsigned char*)WQ, scr, r, F.lane, WQ6_SCALE); continue; } r -= I_Q;
            p0_transpose_item_f8(peer_v, NE, DM, VT8, scr, r, F.lane, V_SCALE);
        }
#if FP6_P1
        cvt_flat_f6_lds(x, (unsigned char*)XB, MT * (DM / 2048), gw, NGW, F.lane, (LAS unsigned char*)scr, X_SCALE);
#else
        cvt_flat_f8(x, (unsigned char*)XB, (size_t)MT * DM / 16, gt, gs, 1.0f);
#endif
#if FP6_P8
        cvt_flat_f6_lds(peer_u, U8, NE * (DM / 2048), gw, NGW, F.lane, (LAS unsigned char*)scr, U6_SCALE);
#else
        cvt_flat_f8(peer_u, U8, (size_t)NE * DM / 16, gt, gs, U_SCALE);
#endif
        cvt_flat(peer_keys, KEYS, (size_t)8 * 2 * 128 * 128 / 8, gt, gs);
        GRID_BAR();
#endif
    }
    if (IN(1)) {
        pg8::Gemm g{XB, WIN, MT, LDP, DM / 2}; pg8::StaticOrder S; S.init(MT, LDP, F.G, (int)blockIdx.x);
#if FP6_P1
        constexpr float s1 = 1.0f / (X_SCALE * WIN6_SCALE);
        pg8::Epi8<pg8::OpStoreProj> E{{PROJ, (bf16*)(ws + WS_RQKV), s1}};
        pg8::gemm_phase<pg8::Epi8<pg8::OpStoreProj>, pg8::StaticOrder, true, true, 2>(F.lds, g, S, E);
#else
        pg8::Epi8<pg8::OpStoreS> E{{PROJ, LDP, 1.0f / WIN_SCALE}};
        pg8::gemm_phase<pg8::Epi8<pg8::OpStoreS>, pg8::StaticOrder, true, true, 1>(F.lds, g, S, E);
#endif
        GRID_BAR();
    }
#if (REP_MASK & 0x2)
    if (IN(1)) {
        pg8::Gemm g{XB, WIN, MT, LDP, DM / 2}; pg8::StaticOrder S; S.init(MT, LDP, F.G, (int)blockIdx.x);
        pg8::Epi8<pg8::OpStoreProj> E{{PROJ, (bf16*)(ws + WS_RQKV), 1.0f / (X_SCALE * WIN6_SCALE)}};
        pg8::gemm_phase<pg8::Epi8<pg8::OpStoreProj>, pg8::StaticOrder, true, true, 2>(F.lds, g, S, E);
        GRID_BAR();
    }
#endif
    if (IN(2)) {
        const mix::MixArgs A{PROJ, ATTO, RETO, (bf16*)(ws + WS_STATE), da_lambda, da_subln_w, ret_gn_w, ret_gn_b};
#if (REP_MASK & 0x100000)
        { int nrep = 4; asm volatile("" : "+s"(nrep));
          for (int rep = 0; rep < nrep; ++rep) { for (int u = F.vcu; u < 256; u += F.G) mix::ret_fused_unit<PROBE_ABL>(F.lds, A, (const bf16*)(ws + WS_RQKV), (bf16*)(ws + WS_STATE), (float*)(ws + WS_RSTATS), u >> 5, (u >> 1) & 15, u & 1);
          __syncthreads(); }
          GRID_BAR(); }
#endif
#if RET_FUSED
        { bf16* RAW = (bf16*)(ws + WS_STATE); float* STATS = (float*)(ws + WS_RSTATS);
          for (int u = F.vcu; u < 256; u += F.G) mix::ret_fused_unit(F.lds, A, (const bf16*)(ws + WS_RQKV), RAW, STATS, u >> 5, (u >> 1) & 15, u & 1);
          for (int u = F.vcu; u < 512; u += F.G) {
              const int bh = u >> 2, j = u & 3;
              mix::attn_unit(F.lds, A, bh >> 4, bh & 15, j);
              mix::attn_unit(F.lds, A, bh >> 4, bh & 15, 7 - j);
          }
          GRID_BAR();
          for (int m = gw; m < MT; m += NGW) mix::ret_norm_row(A, RAW, STATS, (size_t)m, F.lane);
          GRID_BAR();
#if (REP_MASK & 0x200000)
          for (int m = gw; m < MT; m += NGW) mix::ret_norm_row(A, RAW, STATS, (size_t)m, F.lane);
          GRID_BAR();
#endif
          }
#else
        for (int u = F.vcu; u < 256; u += F.G) mix::ret_state_unit(F.lds, A, u >> 5, (u >> 1) & 15, u & 1);
        GRID_BAR();
        for (int u = F.vcu; u < 2048; u += F.G) mix::ret_unit(F.lds, A, u >> 8, (u >> 4) & 15, u & 15);
        GRID_BAR();
#endif
    }
#if (REP_MASK & 0x4)
    if (IN(2)) {
        const mix::MixArgs A{PROJ, (MIX_VAR ? X1F8 : ATTO), RETO, (bf16*)(ws + WS_STATE), da_lambda, da_subln_w, ret_gn_w, ret_gn_b};
        if (!(REP_MASK & 0x8000)) for (int u = F.vcu; u < 512; u += F.G) {
            const int bh = u >> 2, j = u & 3;
            mix::attn_unit<MIX_VAR>(F.lds, A, bh >> 4, bh & 15, j);
            mix::attn_unit<MIX_VAR>(F.lds, A, bh >> 4, bh & 15, 7 - j);
        }
        if (!(REP_MASK & 0x4000)) for (int u = F.vcu; u < 256; u += F.G) mix::ret_state_unit(F.lds, A, u >> 5, (u >> 1) & 15, u & 1);
        GRID_BAR();
        if (!(REP_MASK & 0x4000)) for (int u = F.vcu; u < 2048; u += F.G) mix::ret_unit(F.lds, A, u >> 8, (u >> 4) & 15, u & 15);
        GRID_BAR();
    }
#endif
    if (IN(3)) {
#ifndef P3_ONLY_R
        { pg8::Gemm g{(const bf16*)ATTO, WDA, MT, DM, 2048 / 2}; pg8::StaticOrder S; S.init(MT, DM, F.G, (int)blockIdx.x);
          pg8::Epi8<pg8::OpGateA> E{{PROJ, MERGED, 1.0f / (mix::ATT_SCALE * WDA_SCALE)}};
          pg8::gemm_phase<pg8::Epi8<pg8::OpGateA>, pg8::StaticOrder, true, true, 1>(F.lds, g, S, E); }
#endif
        __syncthreads();
#ifndef P3_ONLY_A
        { pg8::Gemm g{(const bf16*)RETO, WRET, MT, DM, DM / 2}; pg8::StaticOrder S; S.init(MT, DM, F.G, (int)blockIdx.x);
          pg8::Epi8<pg8::OpGateR> E{{PROJ, MERGED, MERGED8, 1.0f / (mix::RET_SCALE * WRET_SCALE), M_SCALE}};
          pg8::gemm_phase<pg8::Epi8<pg8::OpGateR>, pg8::StaticOrder, true, true, 1>(F.lds, g, S, E); }
#endif
        GRID_BAR();
    }
#if (REP_MASK & 0x8)
    if (IN(3)) {
        { pg8::Gemm g{(const bf16*)ATTO, WDA, MT, DM, 2048 / 2}; pg8::StaticOrder S; S.init(MT, DM, F.G, (int)blockIdx.x);
          pg8::Epi8<pg8::OpGateA> E{{PROJ, MERGED, 1.0f / (mix::ATT_SCALE * WDA_SCALE)}};
          pg8::gemm_phase<pg8::Epi8<pg8::OpGateA>, pg8::StaticOrder, true, true, 1>(F.lds, g, S, E); }
        __syncthreads();
        { pg8::Gemm g{(const bf16*)RETO, WRET, MT, DM, DM / 2}; pg8::StaticOrder S; S.init(MT, DM, F.G, (int)blockIdx.x);
          pg8::Epi8<pg8::OpGateR> E{{PROJ, MERGED, MERGED8, 1.0f / (mix::RET_SCALE * WRET_SCALE), M_SCALE}};
          pg8::gemm_phase<pg8::Epi8<pg8::OpGateR>, pg8::StaticOrder, true, true, 1>(F.lds, g, S, E); }
        GRID_BAR();
    }
#endif
    if (IN(4)) {
        pg8::Gemm g{(const bf16*)MERGED8, WOUT, MT, DM, DM / 2}; pg8::StaticOrder S; S.init(MT, DM, F.G, (int)blockIdx.x);
        pg8::Epi8<pg8::OpResF32> E{{x, Z1, 1.0f / (M_SCALE * WOUT_SCALE)}};
        pg8::gemm_phase<pg8::Epi8<pg8::OpResF32>, pg8::StaticOrder, true, true, 1>(F.lds, g, S, E);
        GRID_BAR();
    }
#if (REP_MASK & 0x10)
    if (IN(4)) {
        pg8::Gemm g{(const bf16*)MERGED8, WOUT, MT, DM, DM / 2}; pg8::StaticOrder S; S.init(MT, DM, F.G, (int)blockIdx.x);
#if (REP_MASK & 0x10000)
        pg8::Epi8<pg8::OpNull> E{{Z1}};
        pg8::gemm_phase<pg8::Epi8<pg8::OpNull>, pg8::StaticOrder, true, true, 1>(F.lds, g, S, E);
#elif (REP_MASK & 0x20000)
        pg8::Epi8<pg8::OpResF32NoStore> E{{x, (bf16*)X1F8, 1.0f}};
        pg8::gemm_phase<pg8::Epi8<pg8::OpResF32NoStore>, pg8::StaticOrder, true, true, 1>(F.lds, g, S, E);
#elif (REP_MASK & 0x40000)
        pg8::Epi8<pg8::OpResF32NoLoad> E{{x, (bf16*)(ws + WS_STATE), 1.0f}};
        pg8::gemm_phase<pg8::Epi8<pg8::OpResF32NoLoad>, pg8::StaticOrder, true, true, 1>(F.lds, g, S, E);
#else
        pg8::Epi8<pg8::OpResF32> E{{x, Z1, 1.0f / (M_SCALE * WOUT_SCALE)}};
        pg8::gemm_phase<pg8::Epi8<pg8::OpResF32>, pg8::StaticOrder, true, true, 1>(F.lds, g, S, E);
#endif
        GRID_BAR();
    }
#endif
    if (IN(5)) {
        { f32x4 wv[16], bv[16]; ln_affine(wv, bv, ln1_w, ln1_b, F.lane);
          for (int m = gw; m < MT; m += NGW) ln_row<false>(Z1 + (size_t)m * LDZ, wv, bv, X1B + (size_t)m * DM, X1F8 + (size_t)m * DM, F.lane, F.lds + F.wave * 16384); }
        GRID_BAR();
    }
#if (REP_MASK & 0x800)
    if (IN(5)) {
        { f32x4 wv[16], bv[16]; ln_affine(wv, bv, ln1_w, ln1_b, F.lane);
          for (int m = gw; m < MT; m += NGW) ln_row<false>(Z1 + (size_t)m * LDZ, wv, bv, X1B + (size_t)m * DM, X1F8 + (size_t)m * DM, F.lane, F.lds + F.wave * 16384); }
        GRID_BAR();
    }
#endif
    if (IN(6)) {
        pg8::Gemm g{(const bf16*)X1F8, WQ, MT, 2048, DM / 2}; pg8::StaticOrder S; S.init(MT, 2048, F.G, (int)blockIdx.x);
        pg8::Epi8<pg8::OpStoreS> E{{QP, 2048, 1.0f / (X1_SCALE * WQ6_SCALE)}};
        pg8::gemm_phase<pg8::Epi8<pg8::OpStoreS>, pg8::StaticOrder, true, true, 2>(F.lds, g, S, E);
        GRID_BAR();
    }
    if (IN(7)) {
        for (int g = F.vcu; g < MT / 32; g += F.G) {
            peer::topk_item(QP, KEYS, (LAS unsigned*)F.lds, g, F.wave);
            __syncthreads();
            peer::topk_store_dense((const LAS unsigned*)F.lds, F.lds + 32768, (unsigned char*)GM, g);
        }
        GRID_BAR();
    }
#if (REP_MASK & 0x400)
    if (IN(7)) {
        for (int g = F.vcu; g < MT / 32; g += F.G) {
            peer::topk_item(QP, KEYS, (LAS unsigned*)F.lds, g, F.wave);
            __syncthreads();
            peer::topk_store_dense((const LAS unsigned*)F.lds, F.lds + 32768, (unsigned char*)GM, g);
        }
        GRID_BAR();
    }
#endif
#if (REP_MASK & 0x20)
    if (IN(5) && (REP_MASK & 0x20)) {
        { f32x4 wv[16], bv[16]; ln_affine(wv, bv, ln1_w, ln1_b, F.lane);
          for (int m = gw; m < MT; m += NGW) ln_row<false>(Z1 + (size_t)m * LDZ, wv, bv, X1B + (size_t)m * DM, X1F8 + (size_t)m * DM, F.lane, F.lds + F.wave * 16384); }
        GRID_BAR();
    }
    if (IN(6) && (REP_MASK & 0x20)) {
        pg8::Gemm g{X1B, WQ, MT, 2048, DM}; pg8::StaticOrder S; S.init(MT, 2048, F.G, (int)blockIdx.x);
        pg8::Epi8<pg8::OpStore> E{{QP, 2048}};
        pg8::gemm_phase<pg8::Epi8<pg8::OpStore>, pg8::StaticOrder, true, true>(F.lds, g, S, E);
        GRID_BAR();
    }
    if (IN(7) && (REP_MASK & 0x20)) {
        for (int g = F.vcu; g < MT / 32; g += F.G) {
            peer::topk_item(QP, KEYS, (LAS unsigned*)F.lds, g, F.wave);
            __syncthreads();
            peer::topk_store((const LAS unsigned*)F.lds, (unsigned char*)GM, g);
            __syncthreads();
        }
        GRID_BAR();
    }
#endif
    if (IN(8)) {
        pg8::Gemm g{(const bf16*)X1F8, (const bf16*)U8, MT, NE, DM / 2}; pg8::StaticOrder S; S.init(MT, NE, F.G, (int)blockIdx.x);
#if FP6_P8
        pg8::Epi8<pg8::OpPeerH8> E{{(unsigned char*)GM, 1.0f / (X1_SCALE * U6_SCALE)}};
        pg8::gemm_phase<pg8::Epi8<pg8::OpPeerH8>, pg8::StaticOrder, true, true, 2>(F.lds, g, S, E);
#else
        pg8::Epi8<pg8::OpPeerH8> E{{(unsigned char*)GM, 1.0f / U_SCALE}};
        pg8::gemm_phase<pg8::Epi8<pg8::OpPeerH8>, pg8::StaticOrder, true, true, 1>(F.lds, g, S, E);
#endif
        GRID_BAR();
    }
#if (REP_MASK & 0x100)
    if (IN(8)) {
        pg8::Gemm g{(const bf16*)X1F8, (const bf16*)U8, MT, NE, DM / 2}; pg8::StaticOrder S; S.init(MT, NE, F.G, (int)blockIdx.x);
#if (REP_MASK & 0x10000)
        pg8::Epi8<pg8::OpNull> E{{Z1}};
        pg8::gemm_phase<pg8::Epi8<pg8::OpNull>, pg8::StaticOrder, true, true, 2>(F.lds, g, S, E);
#elif (REP_MASK & 0x20000)
        pg8::Epi8<pg8::OpPeerH8Probe<true>> E{{(const unsigned char*)GM, ws + WS_A8, 1.0f / (X1_SCALE * U6_SCALE)}};
        pg8::gemm_phase<pg8::Epi8<pg8::OpPeerH8Probe<true>>, pg8::StaticOrder, true, true, 2>(F.lds, g, S, E);
#else
        pg8::Epi8<pg8::OpPeerH8Probe<false>> E{{(const unsigned char*)GM, ws + WS_A8, 1.0f / (X1_SCALE * U6_SCALE)}};
        pg8::gemm_phase<pg8::Epi8<pg8::OpPeerH8Probe<false>>, pg8::StaticOrder, true, true, 2>(F.lds, g, S, E);
#endif
        GRID_BAR();
    }
#endif
    if (IN(9)) {
        pg8::Gemm g{(const bf16*)GM, (const bf16*)VT8, MT, DM, NE / 2}; pg8::StaticOrder S; S.init(MT, DM, F.G, (int)blockIdx.x);
        pg8::Epi8<pg8::OpResBfS> E{{X1B, Z1, 1.0f / (A_SCALE * V_SCALE)}};
        pg8::gemm_phase<pg8::Epi8<pg8::OpResBfS>, pg8::StaticOrder, true, true, 1>(F.lds, g, S, E);
        GRID_BAR();
    }
#if (REP_MASK & 0x200)
    if (IN(9)) {
        pg8::Gemm g{(const bf16*)GM, (const bf16*)VT8, MT, DM, NE / 2}; pg8::StaticOrder S; S.init(MT, DM, F.G, (int)blockIdx.x);
        pg8::Epi8<pg8::OpResBfS> E{{X1B, Z1, 1.0f / (A_SCALE * V_SCALE)}};
        pg8::gemm_phase<pg8::Epi8<pg8::OpResBfS>, pg8::StaticOrder, true, true, 1>(F.lds, g, S, E);
        GRID_BAR();
    }
#endif
    if (IN(10)) {
        { f32x4 wv[16], bv[16]; ln_affine(wv, bv, ln2_w, ln2_b, F.lane);
          for (int m = gw; m < MT; m += NGW) ln_row<true>(Z1 + (size_t)m * LDZ, wv, bv, args.out + (size_t)m * DM, nullptr, F.lane, F.lds + F.wave * 16384); }
    }
#if (REP_MASK & 0x1000)
    GRID_BAR();
    if (IN(10)) {
        { f32x4 wv[16], bv[16]; ln_affine(wv, bv, ln2_w, ln2_b, F.lane);
          for (int m = gw; m < MT; m += NGW) ln_row<true>(Z1 + (size_t)m * LDZ, wv, bv, args.out + (size_t)m * DM, nullptr, F.lane, F.lds + F.wave * 16384); }
    }
#endif
#undef IN
#undef GRID_BAR
}

extern "C" void kernel_launch(void* const* d_in, const int* in_sizes, int n_in, void* d_out, int out_size, void* d_ws, size_t ws_size, hipStream_t stream) {
    static int grid = 0;
    if (grid == 0) {
        if (n_in != 17 || in_sizes[0] != MT * DM || out_size != MT * DM || ws_size < WS_END) { fprintf(stderr, "kernel_launch: unexpected shapes (n_in %d, ws %zu)\n", n_in, ws_size); grid = -1; return; }
        int dev = 0, cus = 0, per_cu = 0;
        if (hipGetDevice(&dev) != hipSuccess || hipDeviceGetAttribute(&cus, hipDeviceAttributeMultiprocessorCount, dev) != hipSuccess) { grid = -1; return; }
        if (hipFuncSetAttribute((const void*)mk_fwd, hipFuncAttributeMaxDynamicSharedMemorySize, LDS_BYTES) != hipSuccess) { grid = -1; return; }
        if (hipOccupancyMaxActiveBlocksPerMultiprocessor(&per_cu, (const void*)mk_fwd, NWAVES * 64, LDS_BYTES) != hipSuccess || per_cu < 1) { fprintf(stderr, "kernel_launch: occupancy query says %d\n", per_cu); }
        (void)hipGetLastError();
        grid = cus;
    }
    if (grid < 0) return;
    if (hipMemsetAsync((char*)d_ws + WS_CTL, 0, CTL_ZERO_BYTES, stream) != hipSuccess) return;
    Args a{};
    for (int i = 0; i < 17; ++i) a.in[i] = (const float*)d_in[i];
    a.out = (float*)d_out; a.ws = (unsigned char*)d_ws;
    for (int li = 0; li < N_LAUNCHES; ++li) {
        a.ph_lo = (N_LAUNCHES == 1) ? 0 : li; a.ph_hi = (N_LAUNCHES == 1) ? N_PHASES : li + 1; a.li = li; a.pad = 0;
        hipLaunchKernelGGL(mk_fwd, dim3(grid), dim3(NWAVES * 64), LDS_BYTES, stream, a);
    }
}
```
